# Optimizing an MI355X kernel written in HIP

```python
import math
import jax, jax.numpy as jnp
from jax import lax
import numpy as np

D_MODEL = 1024
BATCH = 8
SEQ = 2048
DEPTH = 4

GRID_W = 64
CTX_LEN = 256
EPS = 1e-6
SHORT_CONV = 3

HY_WIDTH = 512
HY_ORDER = 2
HY_BANDS = 16
HY_EMB = 1 + 2 * HY_BANDS
HY_HIDDEN = 64
HY_SHORT_DECAY_PCT = 0.3
HY_LONG_DECAY_PCT = 1.5
HY_TARGET = 1e-2

SSM_HEADS = 8
SSM_HEAD_DIM = 64
SSM_WIDTH = SSM_HEADS * SSM_HEAD_DIM
SSM_GROUPS = 2
SSM_HPG = SSM_HEADS // SSM_GROUPS
SSM_STATE = 128
SSM_CHUNK = 128

GDN_HEADS = 4
GDN_DK = 128
GDN_DV = 128
GDN_CHUNK = 64

N_BRANCH = 3
D_FF = -(-8 * D_MODEL // (3 * 256)) * 256

HY_COLS = 3 * HY_WIDTH
SSM_XBC = SSM_WIDTH + 2 * SSM_GROUPS * SSM_STATE
SSM_COLS = SSM_WIDTH + SSM_XBC + 2 * SSM_HEADS
GDN_QKV = GDN_HEADS * (2 * GDN_DK + GDN_DV)
GDN_COLS = GDN_QKV + GDN_HEADS * GDN_DV + 4 * GDN_HEADS
GATE_COLS = N_BRANCH * D_MODEL
OFF_SSM = HY_COLS
OFF_GDN = OFF_SSM + SSM_COLS
OFF_GATE = OFF_GDN + GDN_COLS
IN_COLS = OFF_GATE + GATE_COLS

kernel_name = 'hybrid_hyena_ssd_gdn_prefix_dit'


def rmsnorm(x, w):
    xf = x.astype(jnp.float32)
    y = xf * lax.rsqrt(jnp.mean(xf * xf, axis=-1, keepdims=True) + EPS)
    return (y * w.astype(jnp.float32)).astype(x.dtype)


def l2norm(x):
    return x * lax.rsqrt(jnp.sum(x * x, axis=-1, keepdims=True) + EPS)


def rev(a):
    return a[:, ::-1]


def short_conv(u, w, n_rows):
    bsz, L, ch = u.shape
    row = L // n_rows
    pad = SHORT_CONV // 2
    ur = jnp.pad(u.reshape(bsz, n_rows, row, ch), ((0, 0), (0, 0), (pad, pad), (0, 0)))
    y = sum(ur[:, :, j:j + row] * w[j] for j in range(SHORT_CONV))
    return y.reshape(bsz, L, ch)


def hyena_filters(L, w1, b1, w2, b2, w3, freq):
    t = jnp.linspace(0.0, 1.0, L, dtype=jnp.float32)[:, None]
    w = 2.0 * math.pi * jnp.arange(L, dtype=jnp.float32)[:, None] / L
    f = jnp.linspace(1e-4, HY_BANDS - 1, HY_BANDS, dtype=jnp.float32)[None, :]
    z = jnp.concatenate([t, jnp.cos(f * w), -jnp.sin(f * w)], axis=-1)
    h = jnp.sin(freq[0] * (z @ w1 + b1))
    h = jnp.sin(freq[1] * (h @ w2 + b2))
    h = (h @ w3).astype(jnp.float32).reshape(L, HY_ORDER, 2, HY_WIDTH)
    min_decay = math.log(HY_TARGET) / HY_LONG_DECAY_PCT
    max_decay = math.log(HY_TARGET) / HY_SHORT_DECAY_PCT
    deltas = jnp.linspace(min_decay, max_decay, HY_WIDTH, dtype=jnp.float32)
    window = jnp.exp(-t * jnp.abs(deltas))
    return h * window[:, None, None, :]


def bidir_long_conv(u, h, bias):
    L = u.shape[1]
    k = jnp.concatenate([h[:, 0], jnp.zeros_like(h[:1, 0]), h[:0:-1, 1]], axis=0)
    spec = jnp.fft.rfft(u, n=2 * L, axis=1) * jnp.fft.rfft(k, axis=0)[None]
    y = jnp.fft.irfft(spec, n=2 * L, axis=1)[:, :L]
    return y + u * bias


def hyena_mixer(p, n_rows, conv_w, conv_b, w1, b1, w2, b2, w3, freq, bias):
    L = p.shape[1]
    u = (short_conv(p, conv_w, n_rows) + conv_b).astype(jnp.float32)
    v, x1, x2 = jnp.split(u, 3, axis=-1)
    h = hyena_filters(L, w1, b1, w2, b2, w3, freq)
    z = x1 * bidir_long_conv(v, h[:, 0], bias[0])
    z = x2 * bidir_long_conv(z, h[:, 1], bias[1])
    return z.astype(p.dtype)


def ssd_chunked(x, dt, A, Bm, Cm, h0):
    bsz, L = x.shape[:2]
    nc, Q = L // SSM_CHUNK, SSM_CHUNK

    def chunk(a):
        return a.reshape(bsz, nc, Q, *a.shape[2:])

    a_cum = jnp.cumsum(chunk(dt * A), axis=2)
    xd = chunk(x * dt[..., None])
    Bc, Cc = chunk(Bm), chunk(Cm)
    causal = jnp.tril(jnp.ones((Q, Q), dtype=bool))[:, :, None, None]
    decay_ls = jnp.exp(jnp.where(causal, a_cum[:, :, :, None] - a_cum[:, :, None, :], -jnp.inf))
    cb = jnp.einsum('bclgn,bcsgn->bclsg', Cc, Bc)
    y_diag = jnp.einsum('bclsg,bclsge,bcsgep->bclgep', cb, decay_ls, xd)
    a_last = a_cum[:, :, -1]
    states = jnp.einsum('bcsgn,bcsge,bcsgep->bcgepn', Bc, jnp.exp(a_last[:, :, None] - a_cum), xd)

    def step(h, inp):
        st, dec = inp
        return h * dec[..., None, None] + st, h

    h_last, h_in = lax.scan(step, h0, (jnp.moveaxis(states, 1, 0), jnp.moveaxis(jnp.exp(a_last), 1, 0)))
    h_in = jnp.moveaxis(h_in, 0, 1)
    y_off = jnp.einsum('bclgn,bcgepn,bclge->bclgep', Cc, h_in, jnp.exp(a_cum))
    return (y_diag + y_off).reshape(x.shape), h_last


def ssm_prepare(p, n_rows, conv_w, conv_b, dt_bias):
    bsz, L, _ = p.shape
    z = p[..., :SSM_WIDTH]
    xbc = jax.nn.silu(short_conv(p[..., SSM_WIDTH:SSM_WIDTH + SSM_XBC], conv_w, n_rows) + conv_b).astype(jnp.float32)
    nb = SSM_GROUPS * SSM_STATE
    xs = xbc[..., :SSM_WIDTH].reshape(bsz, L, SSM_GROUPS, SSM_HPG, SSM_HEAD_DIM)
    Bm = xbc[..., SSM_WIDTH:SSM_WIDTH + nb].reshape(bsz, L, SSM_GROUPS, SSM_STATE)
    Cm = xbc[..., SSM_WIDTH + nb:].reshape(bsz, L, SSM_GROUPS, SSM_STATE)
    dt_raw = p[..., SSM_WIDTH + SSM_XBC:].astype(jnp.float32).reshape(bsz, L, 2, SSM_GROUPS, SSM_HPG)
    dt = jax.nn.softplus(dt_raw + dt_bias.astype(jnp.float32).reshape(2, SSM_GROUPS, SSM_HPG))
    return z, xs, Bm, Cm, dt


def ssm_bidir(xs, Bm, Cm, dt, A, h0_f, h0_b):
    y_f, h_f = ssd_chunked(xs, dt[:, :, 0], A[0], Bm, Cm, h0_f)
    y_b, h_b = ssd_chunked(rev(xs), rev(dt[:, :, 1]), A[1], rev(Bm), rev(Cm), h0_b)
    return y_f + rev(y_b), h_f, h_b


def ssm_output(y, xs, z, D_skip, norm_w):
    bsz, L = y.shape[:2]
    y = y + xs * D_skip.astype(jnp.float32).reshape(SSM_GROUPS, SSM_HPG)[..., None]
    gw = SSM_HPG * SSM_HEAD_DIM
    y = y.reshape(bsz, L, SSM_GROUPS, gw) * jax.nn.silu(z.astype(jnp.float32)).reshape(bsz, L, SSM_GROUPS, gw)
    y = rmsnorm(y, norm_w.reshape(SSM_GROUPS, gw))
    return y.reshape(bsz, L, SSM_WIDTH)


def ssm_mixer(p_ctx, p_lat, n_rows, conv_w, conv_b, dt_bias, A_log, D_skip, norm_w):
    A = -jnp.exp(A_log.astype(jnp.float32)).reshape(2, SSM_GROUPS, SSM_HPG)
    zc, xc, Bc, Cc, dtc = ssm_prepare(p_ctx, 1, conv_w, conv_b, dt_bias)
    zl, xl, Bl, Cl, dtl = ssm_prepare(p_lat, n_rows, conv_w, conv_b, dt_bias)
    h0 = jnp.zeros((p_ctx.shape[0], SSM_GROUPS, SSM_HPG, SSM_HEAD_DIM, SSM_STATE), jnp.float32)
    yc, h_f, h_b = ssm_bidir(xc, Bc, Cc, dtc, A, h0, h0)
    yl, _, _ = ssm_bidir(xl, Bl, Cl, dtl, A, h_f, h_b)
    return (ssm_output(yc, xc, zc, D_skip, norm_w).astype(p_ctx.dtype),
            ssm_output(yl, xl, zl, D_skip, norm_w).astype(p_lat.dtype))


def gdn_chunked(q, k, v, g, beta, S0):
    bsz, L, H, _ = q.shape
    nc, C = L // GDN_CHUNK, GDN_CHUNK

    def chunk(a):
        return jnp.moveaxis(a.reshape(bsz, nc, C, H, *a.shape[3:]), 3, 2)

    q, k, v, g, beta = chunk(q), chunk(k), chunk(v), chunk(g), chunk(beta)
    g_cum = jnp.cumsum(g, axis=-1)
    incl = jnp.tril(jnp.ones((C, C), dtype=bool))
    decay = jnp.exp(jnp.where(incl, g_cum[..., :, None] - g_cum[..., None, :], -jnp.inf))
    kb = k * beta[..., None]
    mat = jnp.einsum('bnhid,bnhjd->bnhij', kb, k) * decay
    rhs = jnp.concatenate([v * beta[..., None], kb * jnp.exp(g_cum)[..., None]], axis=-1)
    sol = lax.linalg.triangular_solve(mat, rhs, left_side=True, lower=True, unit_diagonal=True)
    u, w = sol[..., :GDN_DV], sol[..., GDN_DV:]
    qk = jnp.einsum('bnhid,bnhjd->bnhij', q, k) * decay
    qg = q * jnp.exp(g_cum)[..., None]
    g_last = g_cum[..., -1]
    kd = k * jnp.exp(g_last[..., None] - g_cum)[..., None]

    def step(S, inp):
        u_c, w_c, qk_c, qg_c, kd_c, gl_c = inp
        v_new = u_c - jnp.einsum('bhck,bhkv->bhcv', w_c, S)
        o = jnp.einsum('bhck,bhkv->bhcv', qg_c, S) + jnp.einsum('bhij,bhjv->bhiv', qk_c, v_new)
        S = S * jnp.exp(gl_c)[..., None, None] + jnp.einsum('bhck,bhcv->bhkv', kd_c, v_new)
        return S, o

    xs = (jnp.moveaxis(u, 1, 0), jnp.moveaxis(w, 1, 0), jnp.moveaxis(qk, 1, 0),
          jnp.moveaxis(qg, 1, 0), jnp.moveaxis(kd, 1, 0), jnp.moveaxis(g_last, 1, 0))
    S_last, o = lax.scan(step, S0, xs)
    o = jnp.moveaxis(jnp.moveaxis(o, 0, 1), 2, 3).reshape(bsz, L, H, GDN_DV)
    return o, S_last


def gdn_prepare(p, n_rows, conv_w, dt_bias, A_log):
    bsz, L, _ = p.shape
    nq = GDN_HEADS * GDN_DK
    nv = GDN_HEADS * GDN_DV
    qkv = jax.nn.silu(short_conv(p[..., :GDN_QKV], conv_w, n_rows)).astype(jnp.float32)
    q = l2norm(qkv[..., :nq].reshape(bsz, L, GDN_HEADS, GDN_DK)) * GDN_DK ** -0.5
    k = l2norm(qkv[..., nq:2 * nq].reshape(bsz, L, GDN_HEADS, GDN_DK))
    v = qkv[..., 2 * nq:].reshape(bsz, L, GDN_HEADS, GDN_DV)
    gate = p[..., GDN_QKV:GDN_QKV + nv]
    o0 = GDN_QKV + nv
    a = p[..., o0:o0 + 2 * GDN_HEADS].astype(jnp.float32).reshape(bsz, L, 2, GDN_HEADS)
    b = p[..., o0 + 2 * GDN_HEADS:].astype(jnp.float32).reshape(bsz, L, 2, GDN_HEADS)
    g = -jnp.exp(A_log.astype(jnp.float32)) * jax.nn.softplus(a + dt_bias.astype(jnp.float32))
    beta = jax.nn.sigmoid(b)
    return q, k, v, g, beta, gate


def gdn_bidir(q, k, v, g, beta, S_f, S_b):
    o_f, S_f = gdn_chunked(q, k, v, g[:, :, 0], beta[:, :, 0], S_f)
    o_b, S_b = gdn_chunked(rev(q), rev(k), rev(v), rev(g[:, :, 1]), rev(beta[:, :, 1]), S_b)
    return o_f + rev(o_b), S_f, S_b


def gdn_output(o, gate, norm_w):
    bsz, L = o.shape[:2]
    o = rmsnorm(o, norm_w) * jax.nn.silu(gate.astype(jnp.float32)).reshape(bsz, L, GDN_HEADS, GDN_DV)
    return o.reshape(bsz, L, GDN_HEADS * GDN_DV)


def gdn_mixer(p_ctx, p_lat, n_rows, conv_w, dt_bias, A_log, norm_w):
    qc, kc, vc, gc, bc, gtc = gdn_prepare(p_ctx, 1, conv_w, dt_bias, A_log)
    ql, kl, vl, gl, bl, gtl = gdn_prepare(p_lat, n_rows, conv_w, dt_bias, A_log)
    S0 = jnp.zeros((p_ctx.shape[0], GDN_HEADS, GDN_DK, GDN_DV), jnp.float32)
    oc, S_f, S_b = gdn_bidir(qc, kc, vc, gc, bc, S0, S0)
    ol, _, _ = gdn_bidir(ql, kl, vl, gl, bl, S_f, S_b)
    return (gdn_output(oc, gtc, norm_w).astype(p_ctx.dtype),
            gdn_output(ol, gtl, norm_w).astype(p_lat.dtype))


def branch_merge(p_gate, y_hy, y_ssm, y_gdn, w_hy_out, w_ssm_out, w_gdn_out, w_out):
    gates = jax.nn.sigmoid(p_gate.reshape(*p_gate.shape[:-1], N_BRANCH, D_MODEL))
    m = (gates[..., 0, :] * (y_hy @ w_hy_out)
         + gates[..., 1, :] * (y_ssm @ w_ssm_out)
         + gates[..., 2, :] * (y_gdn @ w_gdn_out))
    return m @ w_out


def swiglu(h, w_gate_up, w_down):
    gu = h @ w_gate_up
    return (jax.nn.silu(gu[..., :D_FF]) * gu[..., D_FF:]) @ w_down


def setup_inputs(seed: int = 0) -> dict:
    key = jax.random.key(seed)
    ks = iter(jax.random.split(key, 40))
    D = D_MODEL
    L_ = DEPTH

    def nrm(shape, s):
        return jax.random.normal(next(ks), shape, jnp.float32) * s

    def gain(shape):
        return 1.0 + nrm(shape, 0.02)

    def dt_bias(shape):
        dt = jnp.exp(jax.random.uniform(next(ks), shape, jnp.float32, math.log(1e-3), math.log(1e-1)))
        return dt + jnp.log(-jnp.expm1(-dt))

    def a_log(shape):
        return jnp.log(jax.random.uniform(next(ks), shape, jnp.float32, 1.0, 16.0))

    return {
        'x': nrm((BATCH, SEQ, D), 1.0),
        'c': nrm((BATCH, D), 1.0),
        'ctx': nrm((BATCH, CTX_LEN, D), 1.0),
        'c_ctx': nrm((D,), 1.0),
        'w_ada': nrm((L_, D, 6 * D), 0.5 * D ** -0.5),
        'b_ada': nrm((L_, 6 * D), 0.02),
        'norm1_w': gain((L_, D)),
        'norm2_w': gain((L_, D)),
        'w_in': nrm((L_, D, IN_COLS), D ** -0.5),
        'hy_conv_w': nrm((L_, SHORT_CONV, HY_COLS), SHORT_CONV ** -0.5),
        'hy_conv_b': nrm((L_, HY_COLS), 0.02),
        'hy_w1': nrm((L_, HY_EMB, HY_HIDDEN), HY_EMB ** -0.5),
        'hy_b1': nrm((L_, HY_HIDDEN), HY_EMB ** -0.5),
        'hy_w2': nrm((L_, HY_HIDDEN, HY_HIDDEN), HY_HIDDEN ** -0.5),
        'hy_b2': nrm((L_, HY_HIDDEN), HY_HIDDEN ** -0.5),
        'hy_w3': nrm((L_, HY_HIDDEN, HY_ORDER * 2 * HY_WIDTH), 0.04 * HY_HIDDEN ** -0.5),
        'hy_freq': gain((L_, 2, HY_HIDDEN)),
        'hy_bias': nrm((L_, HY_ORDER, HY_WIDTH), 0.5),
        'ssm_conv_w': nrm((L_, SHORT_CONV, SSM_XBC), SHORT_CONV ** -0.5),
        'ssm_conv_b': nrm((L_, SSM_XBC), 0.02),
        'ssm_dt_bias': dt_bias((L_, 2, SSM_HEADS)),
        'ssm_A_log': a_log((L_, 2, SSM_HEADS)),
        'ssm_D': gain((L_, SSM_HEADS)),
        'ssm_norm_w': gain((L_, SSM_WIDTH)),
        'gdn_conv_w': nrm((L_, SHORT_CONV, GDN_QKV), SHORT_CONV ** -0.5),
        'gdn_dt_bias': dt_bias((L_, 2, GDN_HEADS)),
        'gdn_A_log': a_log((L_, 2, GDN_HEADS)),
        'gdn_norm_w': gain((L_, GDN_DV)),
        'w_hy_out': nrm((L_, HY_WIDTH, D), HY_WIDTH ** -0.5),
        'w_ssm_out': nrm((L_, SSM_WIDTH, D), SSM_WIDTH ** -0.5),
        'w_gdn_out': nrm((L_, GDN_HEADS * GDN_DV, D), (GDN_HEADS * GDN_DV) ** -0.5),
        'w_out': nrm((L_, D, D), D ** -0.5),
        'w_gate_up': nrm((L_, D, 2 * D_FF), D ** -0.5),
        'w_down': nrm((L_, D_FF, D), D_FF ** -0.5),
        'final_norm_w': gain((D,)),
    }


def reference(x, c, ctx, c_ctx, w_ada, b_ada, norm1_w, norm2_w, w_in,
              hy_conv_w, hy_conv_b, hy_w1, hy_b1, hy_w2, hy_b2, hy_w3, hy_freq, hy_bias,
              ssm_conv_w, ssm_conv_b, ssm_dt_bias, ssm_A_log, ssm_D, ssm_norm_w,
              gdn_conv_w, gdn_dt_bias, gdn_A_log, gdn_norm_w,
              w_hy_out, w_ssm_out, w_gdn_out, w_out, w_gate_up, w_down, final_norm_w):
    bsz, n_lat, _ = x.shape
    rows = n_lat // GRID_W
    xl, xc = x, ctx
    s_lat = jax.nn.silu(c)
    s_ctx = jax.nn.silu(c_ctx)
    for l in range(DEPTH):
        last = l == DEPTH - 1
        mod_l = (s_lat @ w_ada[l] + b_ada[l]).reshape(bsz, 6, D_MODEL)[:, :, None, :]
        mod_c = (s_ctx @ w_ada[l] + b_ada[l]).reshape(6, D_MODEL)

        hl = rmsnorm(xl, norm1_w[l]) * (1 + mod_l[:, 1]) + mod_l[:, 0]
        hc = rmsnorm(xc, norm1_w[l]) * (1 + mod_c[1]) + mod_c[0]
        pl = hl @ w_in[l]
        pc = hc @ w_in[l]
        ssm_c, ssm_l = ssm_mixer(pc[..., OFF_SSM:OFF_GDN], pl[..., OFF_SSM:OFF_GDN], rows,
                                 ssm_conv_w[l], ssm_conv_b[l], ssm_dt_bias[l], ssm_A_log[l], ssm_D[l], ssm_norm_w[l])
        gdn_c, gdn_l = gdn_mixer(pc[..., OFF_GDN:OFF_GATE], pl[..., OFF_GDN:OFF_GATE], rows,
                                 gdn_conv_w[l], gdn_dt_bias[l], gdn_A_log[l], gdn_norm_w[l])
        hy_l = hyena_mixer(pl[..., :OFF_SSM], rows, hy_conv_w[l], hy_conv_b[l], hy_w1[l], hy_b1[l],
                           hy_w2[l], hy_b2[l], hy_w3[l], hy_freq[l], hy_bias[l])
        xl = xl + mod_l[:, 2] * branch_merge(pl[..., OFF_GATE:], hy_l, ssm_l, gdn_l,
                                             w_hy_out[l], w_ssm_out[l], w_gdn_out[l], w_out[l])
        xl = xl + mod_l[:, 5] * swiglu(rmsnorm(xl, norm2_w[l]) * (1 + mod_l[:, 4]) + mod_l[:, 3],
                                       w_gate_up[l], w_down[l])

        if not last:
            hy_c = hyena_mixer(pc[..., :OFF_SSM], 1, hy_conv_w[l], hy_conv_b[l], hy_w1[l], hy_b1[l],
                               hy_w2[l], hy_b2[l], hy_w3[l], hy_freq[l], hy_bias[l])
            xc = xc + mod_c[2] * branch_merge(pc[..., OFF_GATE:], hy_c, ssm_c, gdn_c,
                                              w_hy_out[l], w_ssm_out[l], w_gdn_out[l], w_out[l])
            xc = xc + mod_c[5] * swiglu(rmsnorm(xc, norm2_w[l]) * (1 + mod_c[4]) + mod_c[3],
                                        w_gate_up[l], w_down[l])
    return rmsnorm(xl, final_norm_w)
```

```cpp
#include <hip/hip_runtime.h>
#include <hip/hip_cooperative_groups.h>
#include <cstdio>
namespace cg = cooperative_groups;

typedef unsigned short bf16_t;
typedef short bf16x8 __attribute__((ext_vector_type(8)));
typedef float f32x4 __attribute__((ext_vector_type(4)));
typedef unsigned u32x2 __attribute__((ext_vector_type(2)));
typedef unsigned u32x4 __attribute__((ext_vector_type(4)));

#define DEVI __device__ __forceinline__

constexpr int D = 1024, NBATCH = 8, SEQ = 2048, CTXL = 256, DEPTH = 4;
constexpr int NLAT = NBATCH * SEQ, NCTX = NBATCH * CTXL, NTOK = NLAT + NCTX;
constexpr int INCOLS = 8224, HYC = 1536, PLD = 6912, DFF = 2816;
constexpr int PC_SSM = 0, PC_GDN = 1552, PC_GATE = 3616;
constexpr int NT = 512;
constexpr float EPS = 1e-6f;
constexpr int SMEM_BYTES = 146 * 1024;

constexpr size_t W_IN = 0, W_BR = W_IN + (size_t)8448 * 1024, W_O = W_BR + (size_t)3 * 1024 * 512,
                 W_GU = W_O + (size_t)1024 * 1024, W_DN = W_GU + (size_t)5632 * 1024, W_TOTAL = W_DN + (size_t)1024 * 2816;
constexpr size_t KG_LAT = 0, KG_CTX = (size_t)2 * 512 * 4096, KG_TOTAL = KG_CTX + (size_t)2 * 512 * 512;

struct Params {
  const float* in[35];
  float* out;
  float* xctx;
  float* mod;
  bf16_t* H;
  bf16_t* PT;
  bf16_t* P;
  bf16_t* YH;
  bf16_t* OG;
  bf16_t* W;
  bf16_t* KG;
  unsigned* bar;
};

DEVI int tidx() { int t = threadIdx.x; asm volatile("" : "+v"(t)); return t; }
DEVI int bidx() { int b = blockIdx.x; asm volatile("" : "+s"(b)); return b; }
typedef __bf16 hwbf16x2 __attribute__((ext_vector_type(2)));
typedef float hwf32x2 __attribute__((ext_vector_type(2)));
DEVI unsigned pack2(float a, float b) { const hwf32x2 v = {a, b}; return __builtin_bit_cast(unsigned, __builtin_convertvector(v, hwbf16x2)); }
DEVI bf16_t f2bf(float f) { return (bf16_t)(pack2(f, f) & 0xffffu); }
DEVI float bf2f(bf16_t h) { return __uint_as_float(((unsigned)h) << 16); }

DEVI float lo2f(unsigned u) { return __uint_as_float(u << 16); }
DEVI float hi2f(unsigned u) { return __uint_as_float(u & 0xffff0000u); }
DEVI float silu_f(float x) { return x * __builtin_amdgcn_rcpf(1.f + __expf(-x)); }
DEVI float sigmoid_f(float x) { return __builtin_amdgcn_rcpf(1.f + __expf(-x)); }
DEVI float softplus_f(float x) { return x > 20.f ? x : log1pf(__expf(x)); }

DEVI void phase_mod(const Params& p, char* smem) {
  const int tid = tidx(), lane = tid & 63, wid = tid >> 6;
  float* s = (float*)smem;
  float* red = s + 9 * 1024;
  for (int i = tid; i < 9 * 1024; i += NT) {
    int r = i >> 10, k = i & 1023;
    float c = r < 8 ? p.in[1][r * 1024 + k] : p.in[3][k];
    s[i] = silu_f(c);
  }
  __syncthreads();
  for (int item = bidx(); item < 4 * 96; item += gridDim.x) {
    const int l = item / 96, cb = (item % 96) * 64;
    const float* w = p.in[4] + (size_t)l * 1024 * 6144 + cb + lane;
    float acc[9];
#pragma unroll
    for (int r = 0; r < 9; ++r) acc[r] = 0.f;
    const int k0 = wid * 128;
#pragma unroll 8
    for (int k = k0; k < k0 + 128; ++k) {
      float wv = w[(size_t)k * 6144];
#pragma unroll
      for (int r = 0; r < 9; ++r) acc[r] += s[r * 1024 + k] * wv;
    }
#pragma unroll
    for (int r = 0; r < 9; ++r) red[(wid * 9 + r) * 64 + lane] = acc[r];
    __syncthreads();
    for (int i = tid; i < 9 * 64; i += NT) {
      int r = i >> 6, c = i & 63;
      float sum = 0.f;
#pragma unroll
      for (int ww = 0; ww < 8; ++ww) sum += red[(ww * 9 + r) * 64 + c];
      p.mod[((size_t)l * 9 + r) * 6144 + cb + c] = sum + p.in[5][(size_t)l * 6144 + cb + c];
    }
    __syncthreads();
  }
}

struct WDesc { const float* src; bf16_t* dst; int Nsrc, K, kt, ntile, mode; };

DEVI WDesc wconv_desc(const Params& p, int l, int item) {
  constexpr int I_IN = 16 * 132, I_BR = 3 * 8 * 16, I_O = 16 * 16, I_GU = 16 * 88;
  WDesc d;
  int it = item;
  if (it < I_IN) { d.src = p.in[8] + (size_t)l * 1024 * INCOLS; d.dst = p.W + W_IN; d.Nsrc = INCOLS; d.K = 1024; d.kt = it % 16; d.ntile = it / 16; d.mode = 0; return d; }
  it -= I_IN;
  if (it < I_BR) { const int br = it / 128, r = it % 128; d.src = p.in[28 + br] + (size_t)l * 512 * 1024; d.dst = p.W + W_BR + (size_t)br * 1024 * 512; d.Nsrc = 1024; d.K = 512; d.kt = r % 8; d.ntile = r / 8; d.mode = 0; return d; }
  it -= I_BR;
  if (it < I_O) { d.src = p.in[31] + (size_t)l * 1024 * 1024; d.dst = p.W + W_O; d.Nsrc = 1024; d.K = 1024; d.kt = it % 16; d.ntile = it / 16; d.mode = 0; return d; }
  it -= I_O;
  if (it < I_GU) { d.src = p.in[32] + (size_t)l * 1024 * 2 * DFF; d.dst = p.W + W_GU; d.Nsrc = 2 * DFF; d.K = 1024; d.kt = it % 16; d.ntile = it / 16; d.mode = 1; return d; }
  it -= I_GU;
  d.src = p.in[33] + (size_t)l * DFF * 1024; d.dst = p.W + W_DN; d.Nsrc = 1024; d.K = DFF; d.kt = it % 44; d.ntile = it / 44; d.mode = 0; return d;
}

DEVI void wconv_load(const WDesc& d, int tid, f32x4 (&v)[2]) {
  const int kk = tid >> 4, n4 = (tid & 15) * 4;
  const int r = d.ntile * 64 + n4;
  int lcol;
  if (d.mode == 0) lcol = r;
  else { int t = r >> 8, w = (r >> 7) & 1, nn = (r >> 4) & 7, i = r & 15; lcol = (nn >= 4 ? DFF : 0) + t * 128 + w * 64 + (nn & 3) * 16 + i; }
#pragma unroll
  for (int h = 0; h < 2; ++h) {
    v[h] = (f32x4){0.f, 0.f, 0.f, 0.f};
    if (lcol < d.Nsrc) v[h] = *(const f32x4*)(d.src + (size_t)(d.kt * 64 + kk + h * 32) * d.Nsrc + lcol);
  }
}

DEVI void wconv_proc(const WDesc& d, int tid, const f32x4 (&v)[2], float* tile) {
  {
    const int kk = tid >> 4, n4 = (tid & 15) * 4;
#pragma unroll
    for (int h = 0; h < 2; ++h) {
      const int k = kk + h * 32;
      tile[k * 65 + n4 + 0] = v[h][0]; tile[k * 65 + n4 + 1] = v[h][1]; tile[k * 65 + n4 + 2] = v[h][2]; tile[k * 65 + n4 + 3] = v[h][3];
    }
  }
  __syncthreads();
  {
    const int n = tid >> 3, k8 = (tid & 7) * 8;
    u32x4 o;
    o[0] = pack2(tile[(k8 + 0) * 65 + n], tile[(k8 + 1) * 65 + n]);
    o[1] = pack2(tile[(k8 + 2) * 65 + n], tile[(k8 + 3) * 65 + n]);
    o[2] = pack2(tile[(k8 + 4) * 65 + n], tile[(k8 + 5) * 65 + n]);
    o[3] = pack2(tile[(k8 + 6) * 65 + n], tile[(k8 + 7) * 65 + n]);
    *(u32x4*)(d.dst + (size_t)(d.ntile * 64 + n) * d.K + d.kt * 64 + k8) = o;
  }
}

DEVI void phase_wconv(const Params& p, int l, char* smem) {
  constexpr int I_TOT = 16 * 132 + 3 * 8 * 16 + 16 * 16 + 16 * 88 + 44 * 16;
  const int tid = tidx();
  float* tiles = (float*)smem;
  int item = bidx();
  if (item >= I_TOT) return;
  WDesc d = wconv_desc(p, l, item);
  f32x4 v[2];
  wconv_load(d, tid, v);
  int par = 0;
  while (true) {
    const int next = item + gridDim.x;
    WDesc dn = d; f32x4 vn[2] = {v[0], v[1]};
    if (next < I_TOT) { dn = wconv_desc(p, l, next); wconv_load(dn, tid, vn); }
    wconv_proc(d, tid, v, tiles + par * (64 * 65));
    par ^= 1;
    if (next >= I_TOT) break;
    d = dn; v[0] = vn[0]; v[1] = vn[1]; item = next;
  }
  __syncthreads();
}

DEVI void phase_filters(const Params& p, int l, char* smem) {
  float* zf = (float*)smem;
  float* h1 = zf + 33 * 16;
  float* h2 = h1 + 64 * 16;
  const int tid = tidx();
  const float* w1 = p.in[11] + (size_t)l * 33 * 64;
  const float* b1 = p.in[12] + (size_t)l * 64;
  const float* w2 = p.in[13] + (size_t)l * 64 * 64;
  const float* b2 = p.in[14] + (size_t)l * 64;
  const float* w3 = p.in[15] + (size_t)l * 64 * 2048;
  const float* fr0 = p.in[16] + (size_t)l * 128;
  const float* fr1 = fr0 + 64;
  for (int item = bidx(); item < 144; item += gridDim.x) {
    const bool lat = item < 128;
    const int L = lat ? 2048 : 256;
    const int pos0 = lat ? item * 16 : (item - 128) * 16;
    __syncthreads();
    for (int idx = tid; idx < 33 * 16; idx += NT) {
      const int k = idx >> 4, i = idx & 15;
      const int pos = pos0 + i;
      float v;
      if (k == 0) v = (float)pos / (float)(L - 1);
      else {
        const int band = (k - 1) & 15;
        const float f = 1e-4f + (float)band * ((15.f - 1e-4f) / 15.f);
        const float w = 6.283185307179586f * (float)pos / (float)L;
        const float a = f * w;
        v = (k <= 16) ? __cosf(a) : -__sinf(a);
      }
      zf[k * 16 + i] = v;
    }
    __syncthreads();
    {
      const int i = tid & 15, j0 = (tid >> 4) * 2;
      float a0 = b1[j0], a1 = b1[j0 + 1];
#pragma unroll 11
      for (int k = 0; k < 33; ++k) { const float zv = zf[k * 16 + i]; a0 += zv * w1[k * 64 + j0]; a1 += zv * w1[k * 64 + j0 + 1]; }
      h1[j0 * 16 + i] = __sinf(fr0[j0] * a0); h1[(j0 + 1) * 16 + i] = __sinf(fr0[j0 + 1] * a1);
    }
    __syncthreads();
    {
      const int i = tid & 15, j0 = (tid >> 4) * 2;
      float a0 = b2[j0], a1 = b2[j0 + 1];
#pragma unroll 8
      for (int k = 0; k < 64; ++k) { const float hv = h1[k * 16 + i]; a0 += hv * w2[k * 64 + j0]; a1 += hv * w2[k * 64 + j0 + 1]; }
      h2[j0 * 16 + i] = __sinf(fr1[j0] * a0); h2[(j0 + 1) * 16 + i] = __sinf(fr1[j0 + 1] * a1);
    }
    __syncthreads();
    {
      const int col0 = tid * 4;
      f32x4 acc[16];
#pragma unroll
      for (int i = 0; i < 16; ++i) acc[i] = (f32x4){0.f, 0.f, 0.f, 0.f};
#pragma unroll 2
      for (int k = 0; k < 64; ++k) {
        const f32x4 wv = *(const f32x4*)(w3 + (size_t)k * 2048 + col0);
        const f32x4 ha = *(const f32x4*)(h2 + k * 16), hb = *(const f32x4*)(h2 + k * 16 + 4), hc = *(const f32x4*)(h2 + k * 16 + 8), hd = *(const f32x4*)(h2 + k * 16 + 12);
#pragma unroll
        for (int i = 0; i < 4; ++i) { acc[i] += wv * ha[i]; acc[4 + i] += wv * hb[i]; acc[8 + i] += wv * hc[i]; acc[12 + i] += wv * hd[i]; }
      }
      const int order = col0 >> 10, dir = (col0 >> 9) & 1, ch0 = col0 & 511;
#pragma unroll
      for (int j = 0; j < 4; ++j) {
        const int ch = ch0 + j;
        const float delta = 3.0701134573253945f + (float)ch * ((15.350567286626973f - 3.0701134573253945f) / 511.f);
        bf16_t* kg = lat ? (p.KG + KG_LAT + ((size_t)(order * 512 + ch)) * 4096) : (p.KG + KG_CTX + ((size_t)(order * 512 + ch)) * 512);
#pragma unroll
        for (int i = 0; i < 16; ++i) {
          const int pos = pos0 + i;
          const float tpos = (float)pos / (float)(L - 1);
          const float val = acc[i][j] * __expf(-tpos * delta);
          if (dir == 0) kg[L - pos] = f2bf(val);
          else { if (pos > 0) kg[L + pos] = f2bf(val); else kg[0] = 0; }
        }
      }
    }
  }
  __syncthreads();
}

DEVI void phase_norm(const Params& p, const float* xlat, const float* xctx, const float* nw, const float* modl, int shift_i, int scale_i, int ntok) {
  const int lane = tidx() & 63;
  const int gw = bidx() * (NT / 64) + (tidx() >> 6), nw_tot = gridDim.x * (NT / 64);
  for (int tok0 = gw; tok0 < ntok; tok0 += 2 * nw_tot) {
    const int tok1 = tok0 + nw_tot;
    const bool has1 = tok1 < ntok;
    const int tk[2] = {tok0, has1 ? tok1 : tok0};
    f32x4 v[2][4];
    float ss[2] = {0.f, 0.f};
#pragma unroll
    for (int u = 0; u < 2; ++u) {
      const int tok = tk[u];
      const float* xr = tok < NLAT ? xlat + (size_t)tok * D : xctx + (size_t)(tok - NLAT) * D;
#pragma unroll
      for (int i = 0; i < 4; ++i) v[u][i] = *(const f32x4*)(xr + i * 256 + lane * 4);
    }
#pragma unroll
    for (int u = 0; u < 2; ++u)
#pragma unroll
      for (int i = 0; i < 4; ++i) ss[u] += v[u][i][0] * v[u][i][0] + v[u][i][1] * v[u][i][1] + v[u][i][2] * v[u][i][2] + v[u][i][3] * v[u][i][3];
#pragma unroll
    for (int o = 32; o > 0; o >>= 1) { ss[0] += __shfl_xor(ss[0], o); ss[1] += __shfl_xor(ss[1], o); }
#pragma unroll
    for (int u = 0; u < 2; ++u) {
      if (u == 1 && !has1) break;
      const int tok = tk[u];
      const int r = tok < NLAT ? (tok >> 11) : 8;
      const float* sh = modl + (size_t)r * 6144 + shift_i * 1024;
      const float* sc = modl + (size_t)r * 6144 + scale_i * 1024;
      const float rstd = rsqrtf(ss[u] * (1.f / 1024.f) + EPS);
#pragma unroll
      for (int i = 0; i < 4; ++i) {
        const int c = i * 256 + lane * 4;
        f32x4 w = *(const f32x4*)(nw + c), s1 = *(const f32x4*)(sc + c), s0 = *(const f32x4*)(sh + c);
        float y0 = v[u][i][0] * rstd * w[0] * (1.f + s1[0]) + s0[0];
        float y1 = v[u][i][1] * rstd * w[1] * (1.f + s1[1]) + s0[1];
        float y2 = v[u][i][2] * rstd * w[2] * (1.f + s1[2]) + s0[2];
        float y3 = v[u][i][3] * rstd * w[3] * (1.f + s1[3]) + s0[3];
        u32x2 o = {pack2(y0, y1), pack2(y2, y3)};
        *(u32x2*)(p.H + (size_t)tok * D + c) = o;
      }
    }
  }
}

DEVI int swzf(int r2) { return (0x78 >> (2 * r2)) & 3; }

DEVI void wait_vmcnt(int n) {
  switch (n) {
    case 0: asm volatile("s_waitcnt vmcnt(0)" ::: "memory"); break;
    case 1: asm volatile("s_waitcnt vmcnt(1)" ::: "memory"); break;
    case 2: asm volatile("s_waitcnt vmcnt(2)" ::: "memory"); break;
    case 3: asm volatile("s_waitcnt vmcnt(3)" ::: "memory"); break;
    case 4: asm volatile("s_waitcnt vmcnt(4)" ::: "memory"); break;
    case 5: asm volatile("s_waitcnt vmcnt(5)" ::: "memory"); break;
    case 6: asm volatile("s_waitcnt vmcnt(6)" ::: "memory"); break;
    case 7: asm volatile("s_waitcnt vmcnt(7)" ::: "memory"); break;
    case 8: asm volatile("s_waitcnt vmcnt(8)" ::: "memory"); break;
    case 9: asm volatile("s_waitcnt vmcnt(9)" ::: "memory"); break;
    case 10: asm volatile("s_waitcnt vmcnt(10)" ::: "memory"); break;
    case 11: asm volatile("s_waitcnt vmcnt(11)" ::: "memory"); break;
    case 12: asm volatile("s_waitcnt vmcnt(12)" ::: "memory"); break;
    case 13: asm volatile("s_waitcnt vmcnt(13)" ::: "memory"); break;
    case 14: asm volatile("s_waitcnt vmcnt(14)" ::: "memory"); break;
    case 15: asm volatile("s_waitcnt vmcnt(15)" ::: "memory"); break;
    default: asm volatile("s_waitcnt vmcnt(16)" ::: "memory"); break;
  }
}
template <int MI, int NI, int NSTG = 2>
DEVI void gemm_mainloop(const bf16_t* __restrict__ A, int lda, const bf16_t* __restrict__ B, int ldb, int K, int m0, int n0,
                        char* smem, f32x4 (&acc)[MI][NI], bool pre_issued = false, bool has_next = false, int m0n = 0, int n0n = 0) {
  constexpr int BM = 64 * MI, BN = 32 * NI, STG = (BM + BN) * 128, NA = MI, NB = NI / 2, LPS = NA + NB;
  static_assert(NSTG * STG <= SMEM_BYTES, "LDS ring too large");
  static_assert((NSTG - 2) * LPS <= 16, "vmcnt switch range");
  const int tid = tidx(), lane = tid & 63, wid = tid >> 6, wr = wid >> 1, wc = wid & 1, fr = lane & 15, fq = lane >> 4;
  const bf16_t *ga, *gb;
  {
    const int row = tid >> 3, c = tid & 7;
    const int kc = c ^ ((row >> 1) & 7);
    ga = A + (size_t)(m0 + row) * lda + kc * 8;
    gb = B + (size_t)(n0 + row) * ldb + kc * 8;
  }
  const int nt = K >> 6;
  const int gsw = (fr >> 1) & 7;
  const int a_row = (wr * (16 * MI) + fr) * 128;
  const int b_row = BM * 128 + (wc * (16 * NI) + fr) * 128;
  auto stage = [&](int t) {
    char* sA = smem + (t % NSTG) * STG;
    const int ko = t * 64;
#pragma unroll
    for (int i = 0; i < NA; ++i)
      __builtin_amdgcn_global_load_lds((const unsigned*)(ga + (size_t)i * 64 * lda + ko), (__attribute__((address_space(3))) unsigned*)(sA + i * 8192 + tid * 16), 16, 0, 0);
#pragma unroll
    for (int i = 0; i < NB; ++i)
      __builtin_amdgcn_global_load_lds((const unsigned*)(gb + (size_t)i * 64 * ldb + ko), (__attribute__((address_space(3))) unsigned*)(sA + BM * 128 + i * 8192 + tid * 16), 16, 0, 0);
  };
  if (!pre_issued) {
    __syncthreads();
#pragma unroll
    for (int i = 0; i < NSTG - 1; ++i) if (i < nt) stage(i);
  }
  for (int t = 0; t < nt; ++t) {
    {
      const int rem = nt - 1 - t;
      const int ahead = rem < NSTG - 2 ? rem : NSTG - 2;
      wait_vmcnt(ahead * LPS);
    }
    __builtin_amdgcn_s_barrier();
    asm volatile("" ::: "memory");
    if (t + NSTG - 1 < nt) stage(t + NSTG - 1);
    else if (NSTG == 2 && has_next) {
      const int row = tid >> 3, c = tid & 7;
      const int kc = c ^ ((row >> 1) & 7);
      const bf16_t* gan = A + (size_t)(m0n + row) * lda + kc * 8;
      const bf16_t* gbn = B + (size_t)(n0n + row) * ldb + kc * 8;
#pragma unroll
      for (int i = 0; i < NA; ++i)
        __builtin_amdgcn_global_load_lds((const unsigned*)(gan + (size_t)i * 64 * lda), (__attribute__((address_space(3))) unsigned*)(smem + i * 8192 + tid * 16), 16, 0, 0);
#pragma unroll
      for (int i = 0; i < NB; ++i)
        __builtin_amdgcn_global_load_lds((const unsigned*)(gbn + (size_t)i * 64 * ldb), (__attribute__((address_space(3))) unsigned*)(smem + BM * 128 + i * 8192 + tid * 16), 16, 0, 0);
    }
    const char* sA = smem + (t % NSTG) * STG;
#pragma unroll
    for (int ks = 0; ks < 2; ++ks) {
      const int coff = ((fq + 4 * ks) ^ gsw) * 16;
      bf16x8 a[MI], b[NI];
#pragma unroll
      for (int mi = 0; mi < MI; ++mi) a[mi] = *(const bf16x8*)(sA + a_row + mi * 2048 + coff);
#pragma unroll
      for (int ni = 0; ni < NI; ++ni) b[ni] = *(const bf16x8*)(sA + b_row + ni * 2048 + coff);
      __builtin_amdgcn_s_setprio(1);
#pragma unroll
      for (int mi = 0; mi < MI; ++mi)
#pragma unroll
        for (int ni = 0; ni < NI; ++ni) acc[mi][ni] = __builtin_amdgcn_mfma_f32_16x16x32_bf16(b[ni], a[mi], acc[mi][ni], 0, 0, 0);
      __builtin_amdgcn_s_setprio(0);
    }
  }
}

template <int MI, int NI>
DEVI void zero_acc(f32x4 (&acc)[MI][NI]) {
#pragma unroll
  for (int i = 0; i < MI; ++i)
#pragma unroll
    for (int j = 0; j < NI; ++j) acc[i][j] = (f32x4){0.f, 0.f, 0.f, 0.f};
}

template <class F>
DEVI void for_tiles256(int nM, int nN, F f) {
  const int ntile = nM * nN;
  for (int T = bidx(); T < ntile; T += gridDim.x) {
    int tm, tn;
    if ((nM & 7) == 0) { tm = (T / (8 * nN)) * 8 + (T & 7); tn = (T % (8 * nN)) >> 3; }
    else { tm = T % nM; tn = T / nM; }
    f(tm, tn);
  }
}

template <class F>
DEVI void for_tiles(int nM, int nN, int PH, F f) {
  const int PW = 32 / PH;
  const int nPanM = (nM + PH - 1) / PH, nPanN = (nN + PW - 1) / PW, nchunks = nPanM * nPanN;
  const int cstride = gridDim.x >> 5;
  const int slot = bidx() / cstride;
  for (int chunk = bidx() % cstride; chunk < nchunks; chunk += cstride) {
    const int pm = chunk / nPanN, pn = chunk % nPanN;
    const int tm = pm * PH + (slot % PH), tn = pn * PW + (slot / PH);
    if (tm < nM && tn < nN) f(tm, tn);
  }
}

template <class F>
DEVI void for_tiles_la(int nM, int nN, int PH, F f) {
  const int PW = 32 / PH;
  const int nPanM = (nM + PH - 1) / PH, nPanN = (nN + PW - 1) / PW, nchunks = nPanM * nPanN;
  const int cstride = gridDim.x >> 5;
  const int slot = bidx() / cstride;
  auto tile_of = [&](int chunk, int& tm, int& tn) {
    const int pm = chunk / nPanN, pn = chunk % nPanN;
    tm = pm * PH + (slot % PH); tn = pn * PW + (slot / PH);
    return tm < nM && tn < nN;
  };
  int chunk = bidx() % cstride, tm = 0, tn = 0;
  while (chunk < nchunks && !tile_of(chunk, tm, tn)) chunk += cstride;
  bool pre = false;
  while (chunk < nchunks) {
    int nchunk = chunk + cstride, tmn = 0, tnn = 0;
    while (nchunk < nchunks && !tile_of(nchunk, tmn, tnn)) nchunk += cstride;
    const bool has_next = nchunk < nchunks;
    f(tm, tn, pre, has_next, tmn, tnn);
    pre = has_next; chunk = nchunk; tm = tmn; tn = tnn;
  }
}

template <int MI, int NI>
DEVI void epi_store_bf16(const f32x4 (&acc)[MI][NI], bf16_t* C, size_t ldc, int m0, int n0) {
  const int lane = tidx() & 63, wid = tidx() >> 6, wr = wid >> 1, wc = wid & 1, fr = lane & 15, fq = lane >> 4;
#pragma unroll
  for (int mi = 0; mi < MI; ++mi) {
    const int row = m0 + wr * (16 * MI) + mi * 16 + fr;
#pragma unroll
    for (int ni = 0; ni < NI; ++ni) {
      const int col = n0 + wc * (16 * NI) + ni * 16 + fq * 4;
      u32x2 o = {pack2(acc[mi][ni][0], acc[mi][ni][1]), pack2(acc[mi][ni][2], acc[mi][ni][3])};
      *(u32x2*)(C + (size_t)row * ldc + col) = o;
    }
  }
}

DEVI void phase_gemm_in(const Params& p, char* smem) {
  for_tiles_la(NTOK / 256, PLD / 256, 8, [&](int tm, int tn, bool pre, bool has_next, int tmn, int tnn) {
    f32x4 acc[4][8]; zero_acc<4, 8>(acc);
    gemm_mainloop<4, 8, 2>(p.H, 1024, p.W + W_IN + (size_t)HYC * 1024, 1024, 1024, tm * 256, tn * 256, smem, acc, pre, has_next, tmn * 256, tnn * 256);
    epi_store_bf16<4, 8>(acc, p.P, PLD, tm * 256, tn * 256);
  });
  for_tiles_la(HYC / 256, NTOK / 256, 2, [&](int tm, int tn, bool pre, bool has_next, int tmn, int tnn) {
    f32x4 acc[4][8]; zero_acc<4, 8>(acc);
    gemm_mainloop<4, 8, 2>(p.W + W_IN, 1024, p.H, 1024, 1024, tm * 256, tn * 256, smem, acc, pre, has_next, tmn * 256, tnn * 256);
    epi_store_bf16<4, 8>(acc, p.PT, NTOK, tm * 256, tn * 256);
  });
}

DEVI void phase_gemm_merge(const Params& p, int ntok, char* smem) {
  const bf16_t* YS = p.PT + (size_t)512 * NTOK;
  const bf16_t* YG = p.PT + (size_t)1024 * NTOK;
  for_tiles(ntok / 128, D / 128, 4, [&](int tm, int tn) {
    const int m0 = tm * 128, n0 = tn * 128;
    const int lane = tidx() & 63, wid = tidx() >> 6, wr = wid >> 1, wc = wid & 1, fr = lane & 15, fq = lane >> 4;
    f32x4 tot[2][4]; zero_acc<2, 4>(tot);
#pragma unroll 1
    for (int br = 0; br < 3; ++br) {
      f32x4 acc[2][4]; zero_acc<2, 4>(acc);
      const bf16_t* A = br == 0 ? p.YH : (br == 1 ? YS : YG);
      gemm_mainloop<2, 4, 3>(A, 512, p.W + W_BR + (size_t)br * 1024 * 512, 512, 512, m0, n0, smem, acc);
#pragma unroll
      for (int mi = 0; mi < 2; ++mi) {
        const int row = m0 + wr * 32 + mi * 16 + fr;
#pragma unroll
        for (int ni = 0; ni < 4; ++ni) {
          const int col = n0 + wc * 64 + ni * 16 + fq * 4;
          u32x2 g = *(const u32x2*)(p.P + (size_t)row * PLD + PC_GATE + br * 1024 + col);
          tot[mi][ni][0] += sigmoid_f(lo2f(g[0])) * acc[mi][ni][0];
          tot[mi][ni][1] += sigmoid_f(hi2f(g[0])) * acc[mi][ni][1];
          tot[mi][ni][2] += sigmoid_f(lo2f(g[1])) * acc[mi][ni][2];
          tot[mi][ni][3] += sigmoid_f(hi2f(g[1])) * acc[mi][ni][3];
        }
      }
    }
#pragma unroll
    for (int mi = 0; mi < 2; ++mi) {
      const int row = m0 + wr * 32 + mi * 16 + fr;
#pragma unroll
      for (int ni = 0; ni < 4; ++ni) {
        const int col = n0 + wc * 64 + ni * 16 + fq * 4;
        u32x2 o = {pack2(tot[mi][ni][0], tot[mi][ni][1]), pack2(tot[mi][ni][2], tot[mi][ni][3])};
        *(u32x2*)(p.H + (size_t)row * D + col) = o;
      }
    }
  });
}

DEVI void phase_gemm_resid(const Params& p, const bf16_t* A, int lda, const bf16_t* Bt, int K, int ntok,
                           const float* xin_lat, const float* xin_ctx, const float* modl, int gate_i, char* smem) {
  for_tiles(ntok / 256, D / 128, 4, [&](int tm, int tn) {
    const int m0 = tm * 256, n0 = tn * 128;
    const int lane = tidx() & 63, wid = tidx() >> 6, wr = wid >> 1, wc = wid & 1, fr = lane & 15, fq = lane >> 4;
    f32x4 acc[4][4]; zero_acc<4, 4>(acc);
    gemm_mainloop<4, 4, 3>(A, lda, Bt, K, K, m0, n0, smem, acc);
    const int r = m0 < NLAT ? (m0 >> 11) : 8;
    const float* gate = modl + (size_t)r * 6144 + gate_i * 1024;
#pragma unroll
    for (int mi = 0; mi < 4; ++mi) {
      const int row = m0 + wr * 64 + mi * 16 + fr;
      const float* xi = row < NLAT ? xin_lat + (size_t)row * D : xin_ctx + (size_t)(row - NLAT) * D;
      float* xo = row < NLAT ? p.out + (size_t)row * D : p.xctx + (size_t)(row - NLAT) * D;
#pragma unroll
      for (int ni = 0; ni < 4; ++ni) {
        const int col = n0 + wc * 64 + ni * 16 + fq * 4;
        f32x4 xv = *(const f32x4*)(xi + col), gv = *(const f32x4*)(gate + col);
        f32x4 o;
        o[0] = xv[0] + gv[0] * acc[mi][ni][0]; o[1] = xv[1] + gv[1] * acc[mi][ni][1];
        o[2] = xv[2] + gv[2] * acc[mi][ni][2]; o[3] = xv[3] + gv[3] * acc[mi][ni][3];
        *(f32x4*)(xo + col) = o;
      }
    }
  });
}

DEVI void phase_gemm_gateup(const Params& p, int ntok, char* smem) {
  bf16_t* hid = p.P;
  for_tiles_la(ntok / 256, (2 * DFF) / 256, 8, [&](int tm, int tn, bool pre, bool has_next, int tmn, int tnn) {
    const int m0 = tm * 256, n0 = tn * 256;
    const int lane = tidx() & 63, wid = tidx() >> 6, wr = wid >> 1, wc = wid & 1, fr = lane & 15, fq = lane >> 4;
    f32x4 acc[4][8]; zero_acc<4, 8>(acc);
    gemm_mainloop<4, 8, 2>(p.H, 1024, p.W + W_GU, 1024, 1024, m0, n0, smem, acc, pre, has_next, tmn * 256, tnn * 256);
#pragma unroll
    for (int mi = 0; mi < 4; ++mi) {
      const int row = m0 + wr * 64 + mi * 16 + fr;
#pragma unroll
      for (int ni = 0; ni < 4; ++ni) {
        const int col = tn * 128 + wc * 64 + ni * 16 + fq * 4;
        f32x4 g = acc[mi][ni], u = acc[mi][ni + 4];
        u32x2 o = {pack2(silu_f(g[0]) * u[0], silu_f(g[1]) * u[1]), pack2(silu_f(g[2]) * u[2], silu_f(g[3]) * u[3])};
        *(u32x2*)(hid + (size_t)row * DFF + col) = o;
      }
    }
  });
}

DEVI void conv4_T(const bf16_t* __restrict__ row, int tb, int t, int L, bool lat, float w0, float w1, float w2, float bias, float (&out)[4]) {
  u32x2 mid = *(const u32x2*)(row + tb + t);
  float r[6];
  r[1] = lo2f(mid[0]); r[2] = hi2f(mid[0]); r[3] = lo2f(mid[1]); r[4] = hi2f(mid[1]);
  const bool lv = lat ? ((t & 63) != 0) : (t != 0);
  const bool rv = lat ? (((t + 4) & 63) != 0) : (t + 4 < L);
  r[0] = lv ? bf2f(row[tb + t - 1]) : 0.f;
  r[5] = rv ? bf2f(row[tb + t + 4]) : 0.f;
#pragma unroll
  for (int i = 0; i < 4; ++i) out[i] = w0 * r[i] + w1 * r[i + 1] + w2 * r[i + 2] + bias;
}

template <int L>
DEVI void hyena_channel(const Params& p, int l, int c, char* smem) {
  constexpr bool LAT = (L == 2048);
  constexpr int USTRIDE = (L + 32) * 2;
  constexpr int KCSTRIDE = (2 * L + 16) * 2 + 16;
  constexpr int NJ = 2 * L + 16;
  constexpr int NGI = L / 256;
  char* U = smem;
  char* KC = smem + 8 * USTRIDE;
  const int tid = tidx(), lane = tid & 63, wid = tid >> 6, fr = lane & 15, fq = lane >> 4;
  const int tok0 = LAT ? 0 : NLAT;
  const float* cw = p.in[9] + (size_t)l * 3 * HYC;
  const float* cbias = p.in[10] + (size_t)l * HYC;
  const float* hb = p.in[17] + (size_t)l * 2 * 512;
  const bf16_t* rowv = p.PT + (size_t)c * NTOK;
  const bf16_t* rowx1 = p.PT + (size_t)(512 + c) * NTOK;
  const bf16_t* rowx2 = p.PT + (size_t)(1024 + c) * NTOK;
  bf16_t* rowo = p.PT + (size_t)c * NTOK;
  const bf16_t* kg0 = LAT ? (p.KG + KG_LAT + (size_t)c * 4096) : (p.KG + KG_CTX + (size_t)c * 512);
  const bf16_t* kg1 = LAT ? (p.KG + KG_LAT + (size_t)(512 + c) * 4096) : (p.KG + KG_CTX + (size_t)(512 + c) * 512);

  __syncthreads();
  {
    const float w0 = cw[c], w1 = cw[HYC + c], w2 = cw[2 * HYC + c], bs = cbias[c];
#pragma unroll 4
    for (int u = tid; u < 8 * L / 4; u += NT) {
      const int b = u / (L / 4), t = (u % (L / 4)) * 4;
      float o[4];
      conv4_T(rowv, tok0 + b * L, t, L, LAT, w0, w1, w2, bs, o);
      u32x2 pk = {pack2(o[0], o[1]), pack2(o[2], o[3])};
      *(u32x2*)(U + b * USTRIDE + t * 2) = pk;
    }
  }
  unsigned* KRraw = (unsigned*)(KC + 8 * KCSTRIDE);
  auto load_kr = [&](const bf16_t* kg) {
    if (tid < 2 * L / 8) *(u32x4*)(KRraw + 4 + tid * 4) = *(const u32x4*)(kg + tid * 8);
    if (tid < 4) { KRraw[tid] = 0u; }
    if (tid >= 4 && tid < 16) { KRraw[L + 4 + (tid - 4)] = 0u; }
  };
  auto build_kc = [&]() {
#pragma unroll 4
    for (int u = tid; u < 8 * (NJ / 2); u += NT) {
      const int s = u / (NJ / 2), jp = u % (NJ / 2);
      const int e0 = 2 * jp + s;
      const unsigned w0 = KRraw[e0 >> 1], w1 = KRraw[(e0 >> 1) + 1];
      const unsigned val = (e0 & 1) ? __builtin_amdgcn_alignbit(w1, w0, 16) : w0;
      *(unsigned*)(KC + s * KCSTRIDE + jp * 4) = val;
    }
  };
  load_kr(kg0);
  __syncthreads();
  build_kc();
  __syncthreads();

  const int sshift = (8 - (fr & 7)) & 7;
  const int c0 = fq - ((fr + sshift) >> 3);
  const char* kc_base = KC + sshift * KCSTRIDE;
  const int ib = fr >> 3, bb = fr & 7;
  const char* u_base = U + bb * USTRIDE;

  f32x4 acc[NGI];
  auto conv_loop = [&]() {
#pragma unroll
    for (int gi = 0; gi < NGI; ++gi) acc[gi] = (f32x4){0.f, 0.f, 0.f, 0.f};
    for (int dd = wid - (L / 32 - 1); dd <= wid + 8 * (NGI - 1) + 1; ++dd) {
      int qpos = L / 8 - 4 * dd + c0 + 1;
      qpos = qpos < 0 ? 0 : (qpos > 2 * L / 8 + 1 ? 2 * L / 8 + 1 : qpos);
      const bf16x8 tf = *(const bf16x8*)(kc_base + qpos * 16);
      bf16x8 uf[NGI];
#pragma unroll
      for (int gi = 0; gi < NGI; ++gi) {
        const int s = 32 * (wid + 8 * gi - dd) + 16 * ib + 8 * fq;
        const bool valid = (s >= 0) && (s < L);
        const int sc = valid ? s : 0;
        uf[gi] = *(const bf16x8*)(u_base + sc * 2);
        if (!valid) uf[gi] = (bf16x8){0, 0, 0, 0, 0, 0, 0, 0};
      }
#pragma unroll
      for (int gi = 0; gi < NGI; ++gi) acc[gi] = __builtin_amdgcn_mfma_f32_16x16x32_bf16(tf, uf[gi], acc[gi], 0, 0, 0);
    }
  };
  conv_loop();
  u32x2 zpk[NGI];
  {
    const float w0 = cw[512 + c], w1 = cw[HYC + 512 + c], w2 = cw[2 * HYC + 512 + c], bs = cbias[512 + c];
    const float hb0 = hb[c];
#pragma unroll
    for (int gi = 0; gi < NGI; ++gi) {
      const int g = wid + 8 * gi;
      const int t = 32 * g + 16 * ib + fq * 4;
      float x1[4];
      conv4_T(rowx1, tok0 + bb * L, t, L, LAT, w0, w1, w2, bs, x1);
      u32x2 vv = *(const u32x2*)(u_base + t * 2);
      float z0 = x1[0] * (acc[gi][0] + hb0 * lo2f(vv[0]));
      float z1 = x1[1] * (acc[gi][1] + hb0 * hi2f(vv[0]));
      float z2 = x1[2] * (acc[gi][2] + hb0 * lo2f(vv[1]));
      float z3 = x1[3] * (acc[gi][3] + hb0 * hi2f(vv[1]));
      zpk[gi] = (u32x2){pack2(z0, z1), pack2(z2, z3)};
    }
  }
  __syncthreads();
#pragma unroll
  for (int gi = 0; gi < NGI; ++gi) {
    const int g = wid + 8 * gi;
    const int t = 32 * g + 16 * ib + fq * 4;
    *(u32x2*)(U + bb * USTRIDE + t * 2) = zpk[gi];
  }
  load_kr(kg1);
  __syncthreads();
  build_kc();
  __syncthreads();
  conv_loop();
  {
    const float w0 = cw[1024 + c], w1 = cw[HYC + 1024 + c], w2 = cw[2 * HYC + 1024 + c], bs = cbias[1024 + c];
    const float hb1 = hb[512 + c];
#pragma unroll
    for (int gi = 0; gi < NGI; ++gi) {
      const int g = wid + 8 * gi;
      const int t = 32 * g + 16 * ib + fq * 4;
      float x2[4];
      conv4_T(rowx2, tok0 + bb * L, t, L, LAT, w0, w1, w2, bs, x2);
      float y0 = x2[0] * (acc[gi][0] + hb1 * lo2f(zpk[gi][0]));
      float y1 = x2[1] * (acc[gi][1] + hb1 * hi2f(zpk[gi][0]));
      float y2 = x2[2] * (acc[gi][2] + hb1 * lo2f(zpk[gi][1]));
      float y3 = x2[3] * (acc[gi][3] + hb1 * hi2f(zpk[gi][1]));
      u32x2 o = {pack2(y0, y1), pack2(y2, y3)};
      *(u32x2*)(rowo + tok0 + bb * L + t) = o;
    }
  }
  __syncthreads();
}

DEVI void conv4_P(const bf16_t* __restrict__ P, int tok, bool lv, bool rv, int col, const float* __restrict__ cw, int cstride, int cc,
                  const float* __restrict__ cb, float (&out)[4]) {
  const bf16_t* q = P + (size_t)tok * PLD + col;
  u32x2 m = *(const u32x2*)q;
  u32x2 a = {0u, 0u}, b = {0u, 0u};
  if (lv) a = *(const u32x2*)(q - PLD);
  if (rv) b = *(const u32x2*)(q + PLD);
  f32x4 w0 = *(const f32x4*)(cw + cc), w1 = *(const f32x4*)(cw + cstride + cc), w2 = *(const f32x4*)(cw + 2 * cstride + cc);
  f32x4 bs = {0.f, 0.f, 0.f, 0.f};
  if (cb) bs = *(const f32x4*)(cb + cc);
  out[0] = w0[0] * lo2f(a[0]) + w1[0] * lo2f(m[0]) + w2[0] * lo2f(b[0]) + bs[0];
  out[1] = w0[1] * hi2f(a[0]) + w1[1] * hi2f(m[0]) + w2[1] * hi2f(b[0]) + bs[1];
  out[2] = w0[2] * lo2f(a[1]) + w1[2] * lo2f(m[1]) + w2[2] * lo2f(b[1]) + bs[2];
  out[3] = w0[3] * hi2f(a[1]) + w1[3] * hi2f(m[1]) + w2[3] * hi2f(b[1]) + bs[3];
}

typedef float f32x2 __attribute__((ext_vector_type(2)));
DEVI float dpp_f(float v, const int ctrl_sel) {
  int r;
  if (ctrl_sel == 0) r = __builtin_amdgcn_update_dpp(0, __float_as_int(v), 0xB1, 0xf, 0xf, true);
  else if (ctrl_sel == 1) r = __builtin_amdgcn_update_dpp(0, __float_as_int(v), 0x4E, 0xf, 0xf, true);
  else r = __builtin_amdgcn_update_dpp(0, __float_as_int(v), 0x141, 0xf, 0xf, true);
  return __int_as_float(r);
}
DEVI float red8(float v) { v += dpp_f(v, 0); v += dpp_f(v, 1); v += dpp_f(v, 2); return v; }

template <class ColF>
DEVI void scan_load_raw(const bf16_t* __restrict__ P, int tb, int L, bool lat, int dir, int ci, int tid, ColF colf,
                        u32x2 (&m)[5], u32x2 (&a)[5], u32x2 (&b)[5]) {
#pragma unroll
  for (int k = 0; k < 5; ++k) {
    const int u = tid + k * NT;
    const int j = u / 80, qd = u % 80;
    const int t = dir == 0 ? ci * 32 + j : L - 1 - (ci * 32 + j);
    const bool lv = lat ? ((t & 63) != 0) : (t != 0);
    const bool rv = lat ? ((t & 63) != 63) : (t != L - 1);
    const bf16_t* q = P + (size_t)(tb + t) * PLD + colf(qd);
    m[k] = *(const u32x2*)q;
    a[k] = (u32x2){0u, 0u}; b[k] = (u32x2){0u, 0u};
    if (lv) a[k] = *(const u32x2*)(q - PLD);
    if (rv) b[k] = *(const u32x2*)(q + PLD);
  }
}
DEVI f32x4 scan_conv_quad(const float* wt, int qd, u32x2 m, u32x2 a, u32x2 b) {
  const f32x4 w0 = *(const f32x4*)(wt + qd * 16), w1 = *(const f32x4*)(wt + qd * 16 + 4), w2 = *(const f32x4*)(wt + qd * 16 + 8),
              bs = *(const f32x4*)(wt + qd * 16 + 12);
  f32x4 o;
  o[0] = silu_f(w0[0] * lo2f(a[0]) + w1[0] * lo2f(m[0]) + w2[0] * lo2f(b[0]) + bs[0]);
  o[1] = silu_f(w0[1] * hi2f(a[0]) + w1[1] * hi2f(m[0]) + w2[1] * hi2f(b[0]) + bs[1]);
  o[2] = silu_f(w0[2] * lo2f(a[1]) + w1[2] * lo2f(m[1]) + w2[2] * lo2f(b[1]) + bs[2]);
  o[3] = silu_f(w0[3] * hi2f(a[1]) + w1[3] * hi2f(m[1]) + w2[3] * hi2f(b[1]) + bs[3]);
  return o;
}

DEVI void lds_barrier() { asm volatile("s_waitcnt lgkmcnt(0)\n\ts_barrier" ::: "memory"); }
DEVI void phase_act(const Params& p, int l) {
  const int lane = tidx() & 63;
  const int gw = bidx() * (NT / 64) + (tidx() >> 6), nw_tot = gridDim.x * (NT / 64);
  const float* scw = p.in[18] + (size_t)l * 3 * 1024;
  const float* scb = p.in[19] + (size_t)l * 1024;
  const float* gcw = p.in[24] + (size_t)l * 3 * 1536;
  const bool ctxw = gw < 160;
  for (int task = ctxw ? gw : gw - 160; task < (ctxw ? 160 : 5120); task += (ctxw ? 160 : nw_tot - 160)) {
    const int rowi = ctxw ? task / 20 : 8 + task / 20, slab = task % 20;
    int tok0, len;
    if (rowi < 8) { tok0 = NLAT + rowi * CTXL; len = CTXL; } else { tok0 = (rowi - 8) * 64; len = 64; }
    const bool ssm = slab < 8;
    const int cc = (ssm ? slab * 128 : (slab - 8) * 128) + lane * 2;
    const int col = (ssm ? PC_SSM + 512 : PC_GDN) + cc;
    const int nrm = ssm ? 0 : (slab - 8 < 4 ? 1 : (slab - 8 < 8 ? 2 : 0));
    float w0a, w0b, w1a, w1b, w2a, w2b, ba = 0.f, bb = 0.f;
    if (ssm) { w0a = scw[cc]; w0b = scw[cc + 1]; w1a = scw[1024 + cc]; w1b = scw[1024 + cc + 1]; w2a = scw[2048 + cc]; w2b = scw[2048 + cc + 1]; ba = scb[cc]; bb = scb[cc + 1]; }
    else { w0a = gcw[cc]; w0b = gcw[cc + 1]; w1a = gcw[1536 + cc]; w1b = gcw[1536 + cc + 1]; w2a = gcw[3072 + cc]; w2b = gcw[3072 + cc + 1]; }
    unsigned* base = (unsigned*)(p.P + (size_t)tok0 * PLD + col);
    constexpr int RS = PLD / 2;
    unsigned prev = 0u;
    unsigned r[9], rn[8];
#pragma unroll
    for (int i = 0; i < 9; ++i) r[i] = base[(size_t)i * RS];
    for (int t0 = 0; t0 < len; t0 += 8) {
#pragma unroll
      for (int i = 0; i < 8; ++i) {
        const int tt = t0 + 9 + i;
        const bool ok = tt < len;
        const unsigned v = base[(size_t)(ok ? tt : len - 1) * RS];
        rn[i] = ok ? v : 0u;
      }
      float ya[8], yb[8];
#pragma unroll
      for (int i = 0; i < 8; ++i) {
        const unsigned xm = i == 0 ? prev : r[i - 1], xc = r[i], xp = r[i + 1];
        ya[i] = silu_f(w0a * lo2f(xm) + w1a * lo2f(xc) + w2a * lo2f(xp) + ba);
        yb[i] = silu_f(w0b * hi2f(xm) + w1b * hi2f(xc) + w2b * hi2f(xp) + bb);
      }
      if (nrm) {
        float ss[8];
#pragma unroll
        for (int i = 0; i < 8; ++i) ss[i] = ya[i] * ya[i] + yb[i] * yb[i];
#pragma unroll
        for (int o = 32; o > 0; o >>= 1)
#pragma unroll
          for (int i = 0; i < 8; ++i) ss[i] += __shfl_xor(ss[i], o);
#pragma unroll
        for (int i = 0; i < 8; ++i) {
          const float sc = rsqrtf(ss[i] + EPS) * (nrm == 1 ? 0.08838834764831845f : 1.f);
          ya[i] *= sc; yb[i] *= sc;
        }
      }
#pragma unroll
      for (int i = 0; i < 8; ++i) base[(size_t)(t0 + i) * RS] = pack2(ya[i], yb[i]);
      prev = r[7]; r[0] = r[8];
#pragma unroll
      for (int i = 0; i < 8; ++i) r[i + 1] = rn[i];
    }
  }
}

DEVI bf16x8 ldsfrag(const bf16_t* base, int row, int stride_el, int kel) { return *(const bf16x8*)(base + row * stride_el + kel); }

DEVI void ssd_chain(const Params& p, int l, int item, char* smem) {
  const int b = item >> 4, e = (item >> 1) & 7, dir = item & 1, g = e >> 2;
  const int tid = tidx(), lane = tid & 63, wid = tid >> 6, fr = lane & 15, fq = lane >> 4;
  float* wt = (float*)smem;
  float* dts = wt + 1280;
  float* acs = dts + 64;
  bf16_t* Bn = (bf16_t*)(acs + 64);
  bf16_t* Cn = Bn + 64 * 136;
  bf16_t* Hb = Cn + 64 * 136;
  bf16_t* BwT = Hb + 64 * 136;
  bf16_t* XdT = BwT + 128 * 72;
  bf16_t* Xn = XdT + 64 * 72;
  bf16_t* Mm = Xn + 64 * 72;
  const float* cw = p.in[18] + (size_t)l * 3 * 1024;
  const float* cb = p.in[19] + (size_t)l * 1024;
  const float dtb = p.in[20][l * 16 + dir * 8 + e];
  const float Aneg = -__expf(p.in[21][l * 16 + dir * 8 + e]);
  const float Dsk = dir == 0 ? p.in[22][l * 8 + e] : 0.f;
  bf16_t* Yout = p.H + (size_t)dir * NTOK * 512;
  auto ccof = [&](int qd) { return qd < 16 ? e * 64 + qd * 4 : (qd < 48 ? 512 + g * 128 + (qd - 16) * 4 : 768 + g * 128 + (qd - 48) * 4); };
  lds_barrier();
  for (int i = tid; i < 64 * 136 / 2; i += NT) ((unsigned*)Hb)[i] = 0u;
  u32x2 rm[5];
  float rdt = 0.f;
  auto seg_of = [&](int c, int& L, int& tb, bool& lat, int& ci) {
    if (c < 4) { L = CTXL; tb = NLAT + b * CTXL; lat = false; ci = c; } else { L = SEQ; tb = b * SEQ; lat = true; ci = c - 4; }
  };
  auto do_load = [&](int c, int kb) {
    int L, tb, ci; bool lat; seg_of(c, L, tb, lat, ci);
    int tidl = tid; asm volatile("" : "+v"(tidl));
    int rj_ = (tidl + kb * NT) / 80, rq_ = (tidl + kb * NT) - rj_ * 80;
#pragma unroll
    for (int k = 0; k < 5; ++k) {
      const int j = rj_, qd = rq_;
      rq_ += 32; rj_ += 6; if (rq_ >= 80) { rq_ -= 80; rj_ += 1; }
      const int t = dir == 0 ? ci * 64 + j : L - 1 - (ci * 64 + j);
      rm[k] = *(const u32x2*)(p.P + (size_t)(tb + t) * PLD + PC_SSM + 512 + ccof(qd));
    }
    if (kb == 0 && tid < 64) { const int t = dir == 0 ? ci * 64 + tid : L - 1 - (ci * 64 + tid); rdt = bf2f(p.P[(size_t)(tb + t) * PLD + PC_SSM + 1536 + dir * 8 + e]); }
  };
  auto do_dt = [&]() {
    if (tid < 64) {
      const float dt = softplus_f(rdt + dtb);
      float a = dt * Aneg;
#pragma unroll
      for (int o = 1; o < 64; o <<= 1) { const float v = __shfl_up(a, o); if (lane >= o) a += v; }
      dts[tid] = dt; acs[tid] = a;
    }
  };
  auto do_convert = [&](int kb) {
    const float alast = acs[63];
    int tidl = tid; asm volatile("" : "+v"(tidl));
    int rj_ = (tidl + kb * NT) / 80, rq_ = (tidl + kb * NT) - rj_ * 80;
#pragma unroll
    for (int k = 0; k < 5; ++k) {
      const int s = rj_, qd = rq_;
      rq_ += 32; rj_ += 6; if (rq_ >= 80) { rq_ -= 80; rj_ += 1; }
      const u32x2 pk = rm[k];
      const f32x4 o = {lo2f(pk[0]), hi2f(pk[0]), lo2f(pk[1]), hi2f(pk[1])};
      if (qd < 16) {
        const int p0 = qd * 4;
        *(u32x2*)(Xn + s * 72 + p0) = pk;
        const float dt = dts[s];
#pragma unroll
        for (int i = 0; i < 4; ++i) XdT[(p0 + i) * 72 + s] = f2bf(o[i] * dt);
      } else if (qd < 48) {
        const int n0 = (qd - 16) * 4;
        *(u32x2*)(Bn + s * 136 + n0) = pk;
        const float w = __expf(alast - acs[s]);
#pragma unroll
        for (int i = 0; i < 4; ++i) BwT[(n0 + i) * 72 + s] = f2bf(o[i] * w);
      } else {
        const int n0 = (qd - 48) * 4;
        *(u32x2*)(Cn + s * 136 + n0) = pk;
      }
    }
  };
  f32x4 Hacc[4];
#pragma unroll
  for (int i = 0; i < 4; ++i) Hacc[i] = (f32x4){0.f, 0.f, 0.f, 0.f};
  do_load(0, 0);
  do_dt();
  lds_barrier();
  do_convert(0);
  do_load(0, 5);
  do_convert(5);
  lds_barrier();
  for (int c = 0; c < 36; ++c) {
    if (c + 1 < 36) do_load(c + 1, 0);
#pragma unroll
    for (int h = 0; h < 2; ++h) {
      const int tt = wid + 8 * h, tl = tt >> 2, ts = tt & 3;
      f32x4 gacc = {0.f, 0.f, 0.f, 0.f};
      if (ts <= tl) {
#pragma unroll
        for (int kk = 0; kk < 4; ++kk)
          gacc = __builtin_amdgcn_mfma_f32_16x16x32_bf16(ldsfrag(Cn, tl * 16 + fr, 136, kk * 32 + fq * 8), ldsfrag(Bn, ts * 16 + fr, 136, kk * 32 + fq * 8), gacc, 0, 0, 0);
      }
      const int scol = ts * 16 + fr;
      const float as = acs[scol];
#pragma unroll
      for (int jj = 0; jj < 4; ++jj) {
        const int lrow = tl * 16 + fq * 4 + jj;
        const float val = (scol <= lrow) ? gacc[jj] * __expf(acs[lrow] - as) : 0.f;
        Mm[lrow * 72 + scol] = f2bf(val);
      }
    }
    lds_barrier();
    {
      int L, tb, ci; bool lat; seg_of(c, L, tb, lat, ci);
#pragma unroll
      for (int h = 0; h < 2; ++h) {
        const int tt = wid + 8 * h, tp = tt >> 2, tl = tt & 3;
        f32x4 acc = {0.f, 0.f, 0.f, 0.f};
#pragma unroll
        for (int kk = 0; kk < 4; ++kk)
          acc = __builtin_amdgcn_mfma_f32_16x16x32_bf16(ldsfrag(Hb, tp * 16 + fr, 136, kk * 32 + fq * 8), ldsfrag(Cn, tl * 16 + fr, 136, kk * 32 + fq * 8), acc, 0, 0, 0);
        const int lrow = tl * 16 + fr;
        const float sc = __expf(acs[lrow]);
        acc[0] *= sc; acc[1] *= sc; acc[2] *= sc; acc[3] *= sc;
#pragma unroll
        for (int kk = 0; kk < 2; ++kk)
          acc = __builtin_amdgcn_mfma_f32_16x16x32_bf16(ldsfrag(XdT, tp * 16 + fr, 72, kk * 32 + fq * 8), ldsfrag(Mm, tl * 16 + fr, 72, kk * 32 + fq * 8), acc, 0, 0, 0);
        const int p0 = tp * 16 + fq * 4;
        const u32x2 xv = *(const u32x2*)(Xn + lrow * 72 + p0);
        const float y0 = acc[0] + Dsk * lo2f(xv[0]), y1 = acc[1] + Dsk * hi2f(xv[0]), y2 = acc[2] + Dsk * lo2f(xv[1]), y3 = acc[3] + Dsk * hi2f(xv[1]);
        const int t = dir == 0 ? ci * 64 + lrow : L - 1 - (ci * 64 + lrow);
        const u32x2 o = {pack2(y0, y1), pack2(y2, y3)};
        *(u32x2*)(Yout + (size_t)(tb + t) * 512 + e * 64 + p0) = o;
      }
    }
    {
      const float ea = __expf(acs[63]);
#pragma unroll
      for (int tp = 0; tp < 4; ++tp) {
        Hacc[tp][0] *= ea; Hacc[tp][1] *= ea; Hacc[tp][2] *= ea; Hacc[tp][3] *= ea;
#pragma unroll
        for (int kk = 0; kk < 2; ++kk)
          Hacc[tp] = __builtin_amdgcn_mfma_f32_16x16x32_bf16(ldsfrag(BwT, wid * 16 + fr, 72, kk * 32 + fq * 8), ldsfrag(XdT, tp * 16 + fr, 72, kk * 32 + fq * 8), Hacc[tp], 0, 0, 0);
      }
    }
    lds_barrier();
#pragma unroll
    for (int tp = 0; tp < 4; ++tp) {
      const u32x2 o = {pack2(Hacc[tp][0], Hacc[tp][1]), pack2(Hacc[tp][2], Hacc[tp][3])};
      *(u32x2*)(Hb + (tp * 16 + fr) * 136 + wid * 16 + fq * 4) = o;
    }
    if (c + 1 < 36) do_dt();
    lds_barrier();
    if (c + 1 < 36) { do_convert(0); do_load(c + 1, 5); do_convert(5); }
    lds_barrier();
  }
}

template <int STRIDE>
DEVI bf16x8 trfrag(const bf16_t* base, int k0, int c0, int fr, int fq) {
  const unsigned addr = (unsigned)(size_t)(base + (k0 + fq * 8 + (fr >> 2)) * STRIDE + c0 + 4 * (fr & 3));
  u32x2 lo, hi;
  asm volatile("ds_read_b64_tr_b16 %0, %2\n\tds_read_b64_tr_b16 %1, %2 offset:%3\n\ts_waitcnt lgkmcnt(0)" : "=&v"(lo), "=&v"(hi) : "v"(addr), "i"(8 * STRIDE) : "memory");
  u32x4 r = {lo[0], lo[1], hi[0], hi[1]};
  return __builtin_bit_cast(bf16x8, r);
}
DEVI void gdn_chain(const Params& p, int l, int item, char* smem) {
  const int b = item >> 4, hh = (item >> 2) & 3, dir = (item >> 1) & 1, vh = item & 1;
  const int tid = tidx(), lane = tid & 63, wid = tid >> 6, fr = lane & 15, fq = lane >> 4;
  float* wt = (float*)smem;
  float* gcs = wt + 1280;
  float* bts = gcs + 64;
  float* Af = bts + 64;
  float* UT = Af + 64 * 68;
  bf16_t* Kn = (bf16_t*)(UT + 64 * 68);
  bf16_t* Qn = Kn + 64 * 136;
  bf16_t* Wm = Qn + 64 * 136;
  bf16_t* SbT = Wm + 64 * 136;
  bf16_t* KdT = SbT + 64 * 136;
  bf16_t* Vn = KdT + 128 * 72;
  bf16_t* QKd = Vn + 64 * 72;
  bf16_t* vnT = (bf16_t*)Af;
  bf16_t* K0 = KdT; bf16_t* K1 = KdT + 64 * 72;
  bf16_t* S0 = (bf16_t*)Af; bf16_t* S1 = S0 + 64 * 72; bf16_t* S2 = S1 + 64 * 72;
  const float* cw = p.in[24] + (size_t)l * 3 * 1536;
  const float dtb = p.in[25][l * 8 + dir * 4 + hh];
  const float Aexp = __expf(p.in[26][l * 8 + dir * 4 + hh]);
  bf16_t* Oout = p.OG + (size_t)dir * NTOK * 512;
  auto ccof = [&](int qd) { return qd < 32 ? hh * 128 + qd * 4 : (qd < 64 ? 512 + hh * 128 + (qd - 32) * 4 : 1024 + hh * 128 + vh * 64 + (qd - 64) * 4); };
  lds_barrier();
  for (int i = tid; i < 64 * 136 / 2; i += NT) ((unsigned*)SbT)[i] = 0u;
  u32x2 rm[5];
  float rga = 0.f, rgb = 0.f;
  auto seg_of = [&](int c, int& L, int& tb, bool& lat, int& ci) {
    if (c < 4) { L = CTXL; tb = NLAT + b * CTXL; lat = false; ci = c; } else { L = SEQ; tb = b * SEQ; lat = true; ci = c - 4; }
  };
  auto do_load = [&](int c, int kb) {
    int L, tb, ci; bool lat; seg_of(c, L, tb, lat, ci);
    int tidl = tid; asm volatile("" : "+v"(tidl));
    int rj_ = (tidl + kb * NT) / 80, rq_ = (tidl + kb * NT) - rj_ * 80;
#pragma unroll
    for (int k = 0; k < 5; ++k) {
      const int j = rj_, qd = rq_;
      rq_ += 32; rj_ += 6; if (rq_ >= 80) { rq_ -= 80; rj_ += 1; }
      const int t = dir == 0 ? ci * 64 + j : L - 1 - (ci * 64 + j);
      rm[k] = *(const u32x2*)(p.P + (size_t)(tb + t) * PLD + PC_GDN + ccof(qd));
    }
    if (kb == 0 && tid < 64) {
      const int t = dir == 0 ? ci * 64 + tid : L - 1 - (ci * 64 + tid);
      const bf16_t* pr = p.P + (size_t)(tb + t) * PLD + PC_GDN + 2048;
      rga = bf2f(pr[dir * 4 + hh]); rgb = bf2f(pr[8 + dir * 4 + hh]);
    }
  };
  auto do_g = [&]() {
    if (tid < 64) {
      float a = -Aexp * softplus_f(rga + dtb);
#pragma unroll
      for (int o = 1; o < 64; o <<= 1) { const float v = __shfl_up(a, o); if (lane >= o) a += v; }
      gcs[tid] = a; bts[tid] = sigmoid_f(rgb);
    }
  };
  auto do_convert = [&](int kb) {
    int tidl = tid; asm volatile("" : "+v"(tidl));
    int rj_ = (tidl + kb * NT) / 80, rq_ = (tidl + kb * NT) - rj_ * 80;
#pragma unroll
    for (int k = 0; k < 5; ++k) {
      const int s = rj_, qd = rq_;
      rq_ += 32; rj_ += 6; if (rq_ >= 80) { rq_ -= 80; rj_ += 1; }
      const u32x2 pk = rm[k];
      bf16_t* dst = qd < 32 ? Qn + s * 136 + qd * 4 : (qd < 64 ? Kn + s * 136 + (qd - 32) * 4 : Vn + s * 72 + (qd - 64) * 4);
      *(u32x2*)dst = pk;
    }
  };
  auto do_norm = [&]() {
#pragma unroll 2
    for (int rr = 0; rr < 8; ++rr) {
      const int s = wid * 8 + rr;
      const float q0 = bf2f(Qn[s * 136 + lane]), q1 = bf2f(Qn[s * 136 + lane + 64]);
      const float k0 = bf2f(Kn[s * 136 + lane]), k1 = bf2f(Kn[s * 136 + lane + 64]);
      float sq = q0 * q0 + q1 * q1, sk = k0 * k0 + k1 * k1;
#pragma unroll
      for (int o = 32; o > 0; o >>= 1) { sq += __shfl_xor(sq, o); sk += __shfl_xor(sk, o); }
      const float cq = rsqrtf(sq + EPS) * 0.08838834764831845f, ck = rsqrtf(sk + EPS);
      Qn[s * 136 + lane] = f2bf(q0 * cq); Qn[s * 136 + lane + 64] = f2bf(q1 * cq);
      const float kn0 = k0 * ck, kn1 = k1 * ck;
      Kn[s * 136 + lane] = f2bf(kn0); Kn[s * 136 + lane + 64] = f2bf(kn1);
    }
  };
  f32x4 Sacc[4];
#pragma unroll
  for (int i = 0; i < 4; ++i) Sacc[i] = (f32x4){0.f, 0.f, 0.f, 0.f};
  do_load(0, 0);
  do_g();
  lds_barrier();
  do_convert(0);
  do_load(0, 5);
  do_convert(5);
  lds_barrier();
  for (int c = 0; c < 36; ++c) {
    if (c + 1 < 36) do_load(c + 1, 0);
    {
    int tA = tid; asm volatile("" : "+v"(tA));
    const int lane = tA & 63, wid = tA >> 6, fr = lane & 15, fq = lane >> 4;
    for (int i = tA; i < 64 * 72 / 2; i += NT) ((unsigned*)K1)[i] = 0u;
#pragma unroll 1
    for (int h = 0; h < 4; ++h) {
      const int tt = wid + 8 * h, kind = tt >> 4, ti = (tt >> 2) & 3, tj = tt & 3;
      f32x4 acc = {0.f, 0.f, 0.f, 0.f};
      if (tj <= ti) {
        const bf16_t* Arow = kind ? Qn : Kn;
#pragma unroll
        for (int kk = 0; kk < 4; ++kk)
          acc = __builtin_amdgcn_mfma_f32_16x16x32_bf16(ldsfrag(Arow, ti * 16 + fr, 136, kk * 32 + fq * 8), ldsfrag(Kn, tj * 16 + fr, 136, kk * 32 + fq * 8), acc, 0, 0, 0);
      }
      const int jc = tj * 16 + fr;
      const float gj = gcs[jc];
#pragma unroll
      for (int jj = 0; jj < 4; ++jj) {
        const int ir = ti * 16 + fq * 4 + jj;
        const float dcy = __expf(gcs[ir] - gj);
        if (kind == 0) {
          const float av = (jc < ir) ? bts[ir] * acc[jj] * dcy : 0.f;
          Af[ir * 68 + jc] = av;
          K0[ir * 72 + jc] = f2bf(tj < ti ? av : 0.f);
        } else QKd[ir * 72 + jc] = f2bf((jc <= ir) ? acc[jj] * dcy : 0.f);
      }
    }
    }
    lds_barrier();
    {
      int tB = tid; asm volatile("" : "+v"(tB));
      const int lane = tB & 63, wid = tB >> 6, fr = lane & 15, fq = lane >> 4;
      if (tB < 64) {
        const int r = tB >> 4, cc = tB & 15;
        float X[16];
#pragma unroll
        for (int ii = 0; ii < 16; ++ii) {
          float sa = (ii == cc) ? 1.f : 0.f, sb = 0.f;
#pragma unroll
          for (int j4 = 0; j4 < (ii + 3) / 4; ++j4) {
            const f32x4 a4 = *(const f32x4*)(Af + (r * 16 + ii) * 68 + r * 16 + j4 * 4);
            if (j4 * 4 + 0 < ii) sa -= a4[0] * X[j4 * 4 + 0];
            if (j4 * 4 + 1 < ii) sb -= a4[1] * X[j4 * 4 + 1];
            if (j4 * 4 + 2 < ii) sa -= a4[2] * X[j4 * 4 + 2];
            if (j4 * 4 + 3 < ii) sb -= a4[3] * X[j4 * 4 + 3];
          }
          X[ii] = sa + sb;
        }
#pragma unroll
        for (int ii = 0; ii < 16; ++ii) K1[(r * 16 + ii) * 72 + r * 16 + cc] = f2bf(X[ii]);
      }
      lds_barrier();
      auto mm = [&](const bf16_t* Xm, const bf16_t* Ym, int ti, int tj) {
        f32x4 acc = {0.f, 0.f, 0.f, 0.f};
#pragma unroll
        for (int kk = 0; kk < 2; ++kk)
          acc = __builtin_amdgcn_mfma_f32_16x16x32_bf16(ldsfrag(Xm, ti * 16 + fr, 72, kk * 32 + fq * 8), trfrag<72>(Ym, kk * 32, tj * 16, fr, fq), acc, 0, 0, 0);
        return acc;
      };
#pragma unroll 1
      for (int h = 0; h < 2; ++h) {
        const int tt = wid + 8 * h, ti = tt >> 2, tj = tt & 3;
        const f32x4 acc = mm(K1, K0, ti, tj);
#pragma unroll
        for (int jj = 0; jj < 4; ++jj) S0[(ti * 16 + fq * 4 + jj) * 72 + tj * 16 + fr] = f2bf(acc[jj]);
      }
      lds_barrier();
#pragma unroll 1
      for (int h = 0; h < 2; ++h) {
        const int tt = wid + 8 * h, ti = tt >> 2, tj = tt & 3;
        const f32x4 acc = mm(S0, S0, ti, tj);
#pragma unroll
        for (int jj = 0; jj < 4; ++jj) S1[(ti * 16 + fq * 4 + jj) * 72 + tj * 16 + fr] = f2bf(acc[jj]);
      }
      lds_barrier();
#pragma unroll 1
      for (int h = 0; h < 2; ++h) {
        const int tt = wid + 8 * h, ti = tt >> 2, tj = tt & 3;
        const f32x4 acc = mm(S0, S1, ti, tj);
#pragma unroll
        for (int jj = 0; jj < 4; ++jj) {
          const int ir = ti * 16 + fq * 4 + jj, jc = tj * 16 + fr;
          const float v = (ir == jc ? 1.f : 0.f) - bf2f(S0[ir * 72 + jc]) + bf2f(S1[ir * 72 + jc]) - acc[jj];
          S2[ir * 72 + jc] = f2bf(v);
        }
      }
      lds_barrier();
#pragma unroll 1
      for (int h = 0; h < 2; ++h) {
        const int tt = wid + 8 * h, ti = tt >> 2, tj = tt & 3;
        const f32x4 acc = mm(S2, K1, ti, tj);
        const int jc = tj * 16 + fr;
        const float bj = bts[jc], bg = bj * __expf(gcs[jc]);
#pragma unroll
        for (int jj = 0; jj < 4; ++jj) {
          const int ir = ti * 16 + fq * 4 + jj;
          K0[ir * 72 + jc] = f2bf(acc[jj] * bj);
          S0[ir * 72 + jc] = f2bf(acc[jj] * bg);
        }
      }
      lds_barrier();
#pragma unroll 1
      for (int h = 0; h < 6; ++h) {
        const int tt = wid + 8 * h;
        if (tt < 16) {
          const int ti = tt >> 2, tv = tt & 3;
          f32x4 acc = {0.f, 0.f, 0.f, 0.f};
#pragma unroll
          for (int kk = 0; kk < 2; ++kk)
            acc = __builtin_amdgcn_mfma_f32_16x16x32_bf16(ldsfrag(K0, ti * 16 + fr, 72, kk * 32 + fq * 8), trfrag<72>(Vn, kk * 32, tv * 16, fr, fq), acc, 0, 0, 0);
          *(f32x4*)(UT + (tv * 16 + fr) * 68 + ti * 16 + fq * 4) = acc;
        } else {
          const int t2 = tt - 16, ti = t2 >> 3, tk = t2 & 7;
          f32x4 acc = {0.f, 0.f, 0.f, 0.f};
#pragma unroll
          for (int kk = 0; kk < 2; ++kk)
            acc = __builtin_amdgcn_mfma_f32_16x16x32_bf16(ldsfrag(S0, ti * 16 + fr, 72, kk * 32 + fq * 8), trfrag<136>(Kn, kk * 32, tk * 16, fr, fq), acc, 0, 0, 0);
#pragma unroll
          for (int jj = 0; jj < 4; ++jj) Wm[(ti * 16 + fq * 4 + jj) * 136 + tk * 16 + fr] = f2bf(acc[jj]);
        }
      }
    }
    lds_barrier();
    int tC = tid; asm volatile("" : "+v"(tC));
    const int lane = tC & 63, wid = tC >> 6, fr = lane & 15, fq = lane >> 4;
    {
      const float glast = gcs[63];
#pragma unroll 2
      for (int idx = tC; idx < 64 * 128; idx += NT) {
        const int sj = idx >> 7, k = idx & 127;
        KdT[k * 72 + sj] = f2bf(bf2f(Kn[sj * 136 + k]) * __expf(glast - gcs[sj]));
      }
    }
#pragma unroll
    for (int h = 0; h < 2; ++h) {
      const int tt = wid + 8 * h, ti = tt >> 2, tv = tt & 3;
      f32x4 acc = {0.f, 0.f, 0.f, 0.f};
#pragma unroll
      for (int kk = 0; kk < 4; ++kk)
        acc = __builtin_amdgcn_mfma_f32_16x16x32_bf16(ldsfrag(Wm, ti * 16 + fr, 136, kk * 32 + fq * 8), ldsfrag(SbT, tv * 16 + fr, 136, kk * 32 + fq * 8), acc, 0, 0, 0);
      const int v = tv * 16 + fr, i0 = ti * 16 + fq * 4;
      const f32x4 u4 = *(const f32x4*)(UT + v * 68 + i0);
      const u32x2 o = {pack2(u4[0] - acc[0], u4[1] - acc[1]), pack2(u4[2] - acc[2], u4[3] - acc[3])};
      *(u32x2*)(vnT + v * 72 + i0) = o;
    }
    lds_barrier();
    {
      int L, tb, ci; bool lat; seg_of(c, L, tb, lat, ci);
#pragma unroll
      for (int h = 0; h < 2; ++h) {
        const int tt = wid + 8 * h, tv = tt >> 2, ti = tt & 3;
        f32x4 acc = {0.f, 0.f, 0.f, 0.f};
#pragma unroll
        for (int kk = 0; kk < 4; ++kk)
          acc = __builtin_amdgcn_mfma_f32_16x16x32_bf16(ldsfrag(SbT, tv * 16 + fr, 136, kk * 32 + fq * 8), ldsfrag(Qn, ti * 16 + fr, 136, kk * 32 + fq * 8), acc, 0, 0, 0);
        const int ir = ti * 16 + fr;
        const float sc = __expf(gcs[ir]);
        acc[0] *= sc; acc[1] *= sc; acc[2] *= sc; acc[3] *= sc;
#pragma unroll
        for (int kk = 0; kk < 2; ++kk)
          acc = __builtin_amdgcn_mfma_f32_16x16x32_bf16(ldsfrag(vnT, tv * 16 + fr, 72, kk * 32 + fq * 8), ldsfrag(QKd, ti * 16 + fr, 72, kk * 32 + fq * 8), acc, 0, 0, 0);
        const int v0 = tv * 16 + fq * 4;
        const int t = dir == 0 ? ci * 64 + ir : L - 1 - (ci * 64 + ir);
        const u32x2 o = {pack2(acc[0], acc[1]), pack2(acc[2], acc[3])};
        *(u32x2*)(Oout + (size_t)(tb + t) * 512 + hh * 128 + vh * 64 + v0) = o;
      }
      const float eg = __expf(gcs[63]);
#pragma unroll
      for (int tv = 0; tv < 4; ++tv) {
        Sacc[tv][0] *= eg; Sacc[tv][1] *= eg; Sacc[tv][2] *= eg; Sacc[tv][3] *= eg;
#pragma unroll
        for (int kk = 0; kk < 2; ++kk)
          Sacc[tv] = __builtin_amdgcn_mfma_f32_16x16x32_bf16(ldsfrag(KdT, wid * 16 + fr, 72, kk * 32 + fq * 8), ldsfrag(vnT, tv * 16 + fr, 72, kk * 32 + fq * 8), Sacc[tv], 0, 0, 0);
      }
    }
    lds_barrier();
#pragma unroll
    for (int tv = 0; tv < 4; ++tv) {
      const u32x2 o = {pack2(Sacc[tv][0], Sacc[tv][1]), pack2(Sacc[tv][2], Sacc[tv][3])};
      *(u32x2*)(SbT + (tv * 16 + fr) * 136 + wid * 16 + fq * 4) = o;
    }
    if (c + 1 < 36) {
      do_g();
      do_convert(0); do_load(c + 1, 5); do_convert(5);
    }
    lds_barrier();
  }
}

DEVI void phase_mixers(const Params& p, int l, bool last, char* smem) {
  if (gridDim.x == 256) {
    const int bi = bidx();
    if (bi < 128) {
      gdn_chain(p, l, bi, smem);
      __syncthreads();
      hyena_channel<2048>(p, l, bi, smem);
      if (!last) {
        hyena_channel<256>(p, l, bi, smem);
        for (int c = 128 + bi * 3; c < 128 + bi * 3 + 3; ++c) hyena_channel<256>(p, l, c, smem);
      }
    } else {
      ssd_chain(p, l, bi - 128, smem);
      __syncthreads();
      for (int c = 128 + (bi - 128) * 3; c < 128 + (bi - 128) * 3 + 3; ++c) hyena_channel<2048>(p, l, c, smem);
    }
  } else {
    for (int item = bidx(); item < 256; item += gridDim.x) {
      if (item < 128) gdn_chain(p, l, item, smem); else ssd_chain(p, l, item - 128, smem);
    }
    __syncthreads();
    for (int c = bidx(); c < 512; c += gridDim.x) {
      hyena_channel<2048>(p, l, c, smem);
      if (!last) hyena_channel<256>(p, l, c, smem);
    }
  }
}

DEVI void phase_post(const Params& p, int l, int ntok, char* smem) {
  const int tid = tidx(), lane = tid & 63;
  {
    bf16_t* tile = (bf16_t*)smem;
    const int ntt = ntok / 64;
    for (int item = bidx(); item < 8 * ntt; item += gridDim.x) {
      const int ct = item % 8, tt = item / 8;
      __syncthreads();
      {
        const int chl = tid >> 3, t8 = (tid & 7) * 8;
        u32x4 v = *(const u32x4*)(p.PT + (size_t)(ct * 64 + chl) * NTOK + tt * 64 + t8);
        *(u32x4*)(tile + chl * 72 + t8) = v;
      }
      __syncthreads();
      {
        const int tl = tid >> 3, c8 = (tid & 7) * 8;
        u32x4 o;
#pragma unroll
        for (int k = 0; k < 4; ++k) o[k] = (unsigned)tile[(c8 + 2 * k) * 72 + tl] | ((unsigned)tile[(c8 + 2 * k + 1) * 72 + tl] << 16);
        *(u32x4*)(p.YH + (size_t)(tt * 64 + tl) * 512 + ct * 64 + c8) = o;
      }
    }
  }
  {
    const bf16_t* YSf = p.H; const bf16_t* YSb = p.H + (size_t)NTOK * 512;
    const bf16_t* OGf = p.OG; const bf16_t* OGb = p.OG + (size_t)NTOK * 512;
    bf16_t* YS = p.PT + (size_t)512 * NTOK;
    bf16_t* YG = p.PT + (size_t)1024 * NTOK;
    const float* snw = p.in[23] + (size_t)l * 512;
    const float* gnw = p.in[27] + (size_t)l * 128;
    const int gw = bidx() * (NT / 64) + (tid >> 6), nw_tot = gridDim.x * (NT / 64);
    const int c8 = lane * 8;
    for (int tok = gw; tok < ntok; tok += nw_tot) {
      {
        u32x4 a = *(const u32x4*)(YSf + (size_t)tok * 512 + c8), bq = *(const u32x4*)(YSb + (size_t)tok * 512 + c8);
        u32x4 z = *(const u32x4*)(p.P + (size_t)tok * PLD + PC_SSM + c8);
        float v[8]; float ss = 0.f;
#pragma unroll
        for (int k = 0; k < 4; ++k) {
          v[2 * k] = (lo2f(a[k]) + lo2f(bq[k])) * silu_f(lo2f(z[k]));
          v[2 * k + 1] = (hi2f(a[k]) + hi2f(bq[k])) * silu_f(hi2f(z[k]));
          ss += v[2 * k] * v[2 * k] + v[2 * k + 1] * v[2 * k + 1];
        }
#pragma unroll
        for (int o = 16; o > 0; o >>= 1) ss += __shfl_xor(ss, o);
        const float rstd = rsqrtf(ss * (1.f / 256.f) + EPS);
        u32x4 o;
#pragma unroll
        for (int k = 0; k < 4; ++k) o[k] = pack2(v[2 * k] * rstd * snw[c8 + 2 * k], v[2 * k + 1] * rstd * snw[c8 + 2 * k + 1]);
        *(u32x4*)(YS + (size_t)tok * 512 + c8) = o;
      }
      {
        u32x4 a = *(const u32x4*)(OGf + (size_t)tok * 512 + c8), bq = *(const u32x4*)(OGb + (size_t)tok * 512 + c8);
        u32x4 gt = *(const u32x4*)(p.P + (size_t)tok * PLD + PC_GDN + 1536 + c8);
        float v[8]; float ss = 0.f;
#pragma unroll
        for (int k = 0; k < 4; ++k) {
          v[2 * k] = lo2f(a[k]) + lo2f(bq[k]);
          v[2 * k + 1] = hi2f(a[k]) + hi2f(bq[k]);
          ss += v[2 * k] * v[2 * k] + v[2 * k + 1] * v[2 * k + 1];
        }
#pragma unroll
        for (int o = 8; o > 0; o >>= 1) ss += __shfl_xor(ss, o);
        const float rstd = rsqrtf(ss * (1.f / 128.f) + EPS);
        const int ci = c8 & 127;
        u32x4 o;
#pragma unroll
        for (int k = 0; k < 4; ++k)
          o[k] = pack2(v[2 * k] * rstd * gnw[ci + 2 * k] * silu_f(lo2f(gt[k])), v[2 * k + 1] * rstd * gnw[ci + 2 * k + 1] * silu_f(hi2f(gt[k])));
        *(u32x4*)(YG + (size_t)tok * 512 + c8) = o;
      }
    }
  }
}

DEVI void phase_final(const Params& p) {
  const int lane = tidx() & 63;
  const int gw = bidx() * (NT / 64) + (tidx() >> 6), nw_tot = gridDim.x * (NT / 64);
  const float* nw = p.in[34];
  for (int tok = gw; tok < NLAT; tok += nw_tot) {
    float* xr = p.out + (size_t)tok * D;
    f32x4 v[4]; float ss = 0.f;
#pragma unroll
    for (int i = 0; i < 4; ++i) {
      v[i] = *(const f32x4*)(xr + i * 256 + lane * 4);
      ss += v[i][0] * v[i][0] + v[i][1] * v[i][1] + v[i][2] * v[i][2] + v[i][3] * v[i][3];
    }
#pragma unroll
    for (int o = 32; o > 0; o >>= 1) ss += __shfl_xor(ss, o);
    const float rstd = rsqrtf(ss * (1.f / 1024.f) + EPS);
#pragma unroll
    for (int i = 0; i < 4; ++i) {
      f32x4 w = *(const f32x4*)(nw + i * 256 + lane * 4);
      f32x4 o = {v[i][0] * rstd * w[0], v[i][1] * rstd * w[1], v[i][2] * rstd * w[2], v[i][3] * rstd * w[3]};
      *(f32x4*)(xr + i * 256 + lane * 4) = o;
    }
  }
}

#define XB_TMO      128
#define XB_XCNT(j)  (256  + 64 * (j))
#define XB_XSUB(j)  (1280 + 64 * (j))
#define XB_XGEN(j)  (2304 + 64 * (j))
#define XB_TOP      3328
#define XB_TOPGEN   3392
#define XCD_BAR_WORDS 3456
#define XB_SPIN_CAP (1u << 22)
#define XB_LAS __attribute__((address_space(3)))
DEVI unsigned xb_ld(unsigned* p) { return __hip_atomic_load(p, __ATOMIC_RELAXED, __HIP_MEMORY_SCOPE_AGENT); }
DEVI unsigned xb_add(unsigned* p, unsigned v) { return __hip_atomic_fetch_add(p, v, __ATOMIC_RELAXED, __HIP_MEMORY_SCOPE_AGENT); }
DEVI unsigned xb_xcc_id() { return (unsigned)__builtin_amdgcn_s_getreg((3 << 11) | 20) & 0xFu; }
#define XB_SPIN(cond, bar) do { unsigned _sp = 0; while (cond) { __builtin_amdgcn_s_sleep(1); \
    if ((++_sp & 255u) == 0u) { if (xb_ld(&(bar)[XB_TMO])) break; if (_sp > XB_SPIN_CAP) { atomicAdd(&(bar)[XB_TMO], 1u); break; } } } } while (0)
struct XcdBarrier { unsigned* bar; unsigned x; volatile XB_LAS unsigned* st; };
DEVI XcdBarrier xcd_barrier_post(unsigned* bar, volatile XB_LAS unsigned* st) {
  XcdBarrier b; b.bar = bar; b.x = xb_xcc_id(); b.st = st;
  if (threadIdx.x == 0) (void)xb_add(&bar[XB_XCNT(b.x)], 1u);
  return b;
}
DEVI void xcd_barrier_complete(unsigned* bar, unsigned x, unsigned& nloc, unsigned& nx) {
  const unsigned G = gridDim.x * gridDim.y * gridDim.z;
  unsigned sum, cnt, mine, sp = 0u;
  for (;;) {
    sum = 0u; cnt = 0u; mine = 0u;
#pragma unroll
    for (unsigned j = 0; j < 16; ++j) { const unsigned c = xb_ld(&bar[XB_XCNT(j)]); sum += c; cnt += (c > 0u) ? 1u : 0u; mine = (j == x) ? c : mine; }
    if (sum == G) break;
    __builtin_amdgcn_s_sleep(1);
    if ((++sp & 255u) == 0u) { if (xb_ld(&bar[XB_TMO])) break; if (sp > XB_SPIN_CAP) { atomicAdd(&bar[XB_TMO], 1u); break; } }
  }
  nloc = mine > 0u ? mine : 1u; nx = cnt > 0u ? cnt : 1u;
}
DEVI void xcd_barrier(const XcdBarrier& b) {
  asm volatile("s_waitcnt vmcnt(0)" ::: "memory");
  __syncthreads();
  if (threadIdx.x == 0) {
    unsigned* bar = b.bar;
    __builtin_amdgcn_s_waitcnt(0);
    unsigned nloc = b.st[0], nx = b.st[1];
    if (nloc == 0u) { xcd_barrier_complete(bar, b.x, nloc, nx); b.st[0] = nloc; b.st[1] = nx; }
    const unsigned old = xb_add(&bar[XB_XSUB(b.x)], 1u);
    const unsigned gen = old / nloc;
    if (old + 1u == (gen + 1u) * nloc) {
      __builtin_amdgcn_fence(__ATOMIC_RELEASE, "agent");
      asm volatile("s_waitcnt vmcnt(0)" ::: "memory");
      const unsigned og = xb_add(&bar[XB_TOP], 1u);
      const unsigned tg = og / nx;
      if (og + 1u == (tg + 1u) * nx) xb_add(&bar[XB_TOPGEN], 1u);
      else XB_SPIN(xb_ld(&bar[XB_TOPGEN]) == tg, bar);
      __builtin_amdgcn_fence(__ATOMIC_ACQUIRE, "agent");
      xb_add(&bar[XB_XGEN(b.x)], 1u);
      asm volatile("s_waitcnt vmcnt(0)" ::: "memory");
    } else {
      XB_SPIN(xb_ld(&bar[XB_XGEN(b.x)]) == gen, bar);
      __builtin_amdgcn_fence(__ATOMIC_ACQUIRE, "agent");
      asm volatile("s_waitcnt vmcnt(0)" ::: "memory");
    }
  }
  __syncthreads();
}

#ifndef PSEL
#define PSEL -1
#endif
#ifndef PMASK
#define PMASK 0xffffffffu
#endif
#define RUN(n, ...) if ((PSEL < 0 || PSEL == (n)) && ((PMASK >> (n)) & 1u)) { __VA_ARGS__; }
__global__ void __launch_bounds__(NT, 1) fwd_megakernel(Params p) {
  extern __shared__ __attribute__((aligned(16))) char smem[];
  cg::grid_group grid = cg::this_grid();
  __shared__ uint4 xb_words;
  if (threadIdx.x == 0) xb_words = make_uint4(0u, 0u, 0u, 0u);
  __syncthreads();
  const XcdBarrier xb = xcd_barrier_post(p.bar, (volatile XB_LAS unsigned*)&xb_words);
  RUN(0, phase_mod(p, smem));
  for (int l = 0; l < DEPTH; ++l) {
    const bool last = (l == DEPTH - 1);
    const float* xlat = l == 0 ? p.in[0] : p.out;
    const float* xctx = l == 0 ? p.in[2] : p.xctx;
    const float* modl = p.mod + (size_t)l * 9 * 6144;
    __syncthreads();
    RUN(1, phase_wconv(p, l, smem));
    __syncthreads();
    RUN(2, phase_filters(p, l, smem));
    if (l == 0) grid.sync();
    RUN(3, phase_norm(p, xlat, xctx, p.in[6] + (size_t)l * D, modl, 0, 1, NTOK));
    xcd_barrier(xb);
    RUN(4, phase_gemm_in(p, smem));
    xcd_barrier(xb);
    RUN(4, phase_act(p, l));
    xcd_barrier(xb);
    RUN(5, phase_mixers(p, l, last, smem));
    xcd_barrier(xb);
    const int ntok = last ? NLAT : NTOK;
    RUN(6, phase_post(p, l, ntok, smem));
    xcd_barrier(xb);
    RUN(7, phase_gemm_merge(p, ntok, smem));
    xcd_barrier(xb);
    RUN(8, phase_gemm_resid(p, p.H, 1024, p.W + W_O, 1024, ntok, xlat, xctx, modl, 2, smem));
    xcd_barrier(xb);
    RUN(9, phase_norm(p, p.out, p.xctx, p.in[7] + (size_t)l * D, modl, 3, 4, ntok));
    xcd_barrier(xb);
    RUN(10, phase_gemm_gateup(p, ntok, smem));
    xcd_barrier(xb);
    RUN(11, phase_gemm_resid(p, p.P, DFF, p.W + W_DN, DFF, ntok, p.out, p.xctx, modl, 5, smem));
    xcd_barrier(xb);
  }
  RUN(12, phase_final(p));
}

extern "C" void kernel_launch(void* const* d_in, const int* in_sizes, int n_in, void* d_out, int out_size, void* d_ws, size_t ws_size,
                              hipStream_t stream) {
  Params p{};
  for (int i = 0; i < 35; ++i) p.in[i] = (const float*)d_in[i];
  p.out = (float*)d_out;
  char* ws = (char*)d_ws;
  size_t off = 0;
  auto take = [&](size_t bytes) { char* r = ws + off; off += (bytes + 255) & ~(size_t)255; return r; };
  p.xctx = (float*)take((size_t)NCTX * D * 4);
  p.mod = (float*)take((size_t)4 * 9 * 6144 * 4);
  p.H = (bf16_t*)take((size_t)NTOK * D * 2);
  p.PT = (bf16_t*)take((size_t)HYC * NTOK * 2);
  p.P = (bf16_t*)take((size_t)NTOK * PLD * 2);
  p.YH = (bf16_t*)take((size_t)NTOK * 512 * 2);
  p.OG = (bf16_t*)take((size_t)2 * NTOK * 512 * 2);
  p.W = (bf16_t*)take(W_TOTAL * 2);
  p.KG = (bf16_t*)take(KG_TOTAL * 2);
  p.bar = (unsigned*)take(XCD_BAR_WORDS * 4);
  if (off > ws_size) { fprintf(stderr, "workspace too small: need %zu have %zu\n", off, ws_size); return; }
  hipMemsetAsync(p.bar, 0, XCD_BAR_WORDS * 4, stream);
  hipFuncSetAttribute((const void*)fwd_megakernel, hipFuncAttributeMaxDynamicSharedMemorySize, SMEM_BYTES);
  void* args[] = {&p};
  hipError_t e = hipLaunchCooperativeKernel((void*)fwd_megakernel, dim3(256), dim3(NT), args, SMEM_BYTES, stream);
  if (e != hipSuccess) fprintf(stderr, "cooperative launch failed: %s\n", hipGetErrorString(e));
}
```

```cpp
#include <hip/hip_runtime.h>
#include <hip/hip_cooperative_groups.h>
#include <cstdio>
namespace cg = cooperative_groups;

typedef unsigned short bf16_t;
typedef short bf16x8 __attribute__((ext_vector_type(8)));
typedef float f32x4 __attribute__((ext_vector_type(4)));
typedef unsigned u32x2 __attribute__((ext_vector_type(2)));
typedef unsigned u32x4 __attribute__((ext_vector_type(4)));

#define DEVI __device__ __forceinline__

constexpr int D = 1024, NBATCH = 8, SEQ = 2048, CTXL = 256, DEPTH = 4;
constexpr int NLAT = NBATCH * SEQ, NCTX = NBATCH * CTXL, NTOK = NLAT + NCTX;
constexpr int INCOLS = 8224, HYC = 1536, PLD = 6912, DFF = 2816;
constexpr int PC_SSM = 0, PC_GDN = 1552, PC_GATE = 3616;
constexpr int NT = 512;
constexpr float EPS = 1e-6f;
constexpr int SMEM_BYTES = 146 * 1024;

constexpr size_t W_IN = 0, W_BR = W_IN + (size_t)8448 * 1024, W_O = W_BR + (size_t)3 * 1024 * 512,
                 W_GU = W_O + (size_t)1024 * 1024, W_DN = W_GU + (size_t)5632 * 1024, W_TOTAL = W_DN + (size_t)1024 * 2816;
constexpr size_t KG_LAT = 0, KG_CTX = (size_t)2 * 512 * 4096, KG_TOTAL = KG_CTX + (size_t)2 * 512 * 512;

struct Params {
  const float* in[35];
  float* out;
  float* xctx;
  float* mod;
  bf16_t* H;
  bf16_t* PT;
  bf16_t* P;
  bf16_t* YH;
  bf16_t* OG;
  bf16_t* W;
  bf16_t* KG;
  unsigned* bar;
};

DEVI int tidx() { int t = threadIdx.x; asm volatile("" : "+v"(t)); return t; }
DEVI int bidx() { int b = blockIdx.x; asm volatile("" : "+s"(b)); return b; }
typedef __bf16 hwbf16x2 __attribute__((ext_vector_type(2)));
typedef float hwf32x2 __attribute__((ext_vector_type(2)));
DEVI unsigned pack2(float a, float b) { const hwf32x2 v = {a, b}; return __builtin_bit_cast(unsigned, __builtin_convertvector(v, hwbf16x2)); }
DEVI bf16_t f2bf(float f) { return (bf16_t)(pack2(f, f) & 0xffffu); }
DEVI float bf2f(bf16_t h) { return __uint_as_float(((unsigned)h) << 16); }

DEVI float lo2f(unsigned u) { return __uint_as_float(u << 16); }
DEVI float hi2f(unsigned u) { return __uint_as_float(u & 0xffff0000u); }
DEVI float silu_f(float x) { return x * __builtin_amdgcn_rcpf(1.f + __expf(-x)); }
DEVI float sigmoid_f(float x) { return __builtin_amdgcn_rcpf(1.f + __expf(-x)); }
DEVI float softplus_f(float x) { return x > 20.f ? x : log1pf(__expf(x)); }

DEVI void phase_mod(const Params& p, char* smem) {
  const int tid = tidx(), lane = tid & 63, wid = tid >> 6;
  float* s = (float*)smem;
  float* red = s + 9 * 1024;
  for (int i = tid; i < 9 * 1024; i += NT) {
    int r = i >> 10, k = i & 1023;
    float c = r < 8 ? p.in[1][r * 1024 + k] : p.in[3][k];
    s[i] = silu_f(c);
  }
  __syncthreads();
  for (int item = bidx(); item < 4 * 96; item += gridDim.x) {
    const int l = item / 96, cb = (item % 96) * 64;
    const float* w = p.in[4] + (size_t)l * 1024 * 6144 + cb + lane;
    float acc[9];
#pragma unroll
    for (int r = 0; r < 9; ++r) acc[r] = 0.f;
    const int k0 = wid * 128;
#pragma unroll 8
    for (int k = k0; k < k0 + 128; ++k) {
      float wv = w[(size_t)k * 6144];
#pragma unroll
      for (int r = 0; r < 9; ++r) acc[r] += s[r * 1024 + k] * wv;
    }
#pragma unroll
    for (int r = 0; r < 9; ++r) red[(wid * 9 + r) * 64 + lane] = acc[r];
    __syncthreads();
    for (int i = tid; i < 9 * 64; i += NT) {
      int r = i >> 6, c = i & 63;
      float sum = 0.f;
#pragma unroll
      for (int ww = 0; ww < 8; ++ww) sum += red[(ww * 9 + r) * 64 + c];
      p.mod[((size_t)l * 9 + r) * 6144 + cb + c] = sum + p.in[5][(size_t)l * 6144 + cb + c];
    }
    __syncthreads();
  }
}

struct WDesc { const float* src; bf16_t* dst; int Nsrc, K, kt, ntile, mode; };

DEVI WDesc wconv_desc(const Params& p, int l, int item) {
  constexpr int I_IN = 16 * 132, I_BR = 3 * 8 * 16, I_O = 16 * 16, I_GU = 16 * 88;
  WDesc d;
  int it = item;
  if (it < I_IN) { d.src = p.in[8] + (size_t)l * 1024 * INCOLS; d.dst = p.W + W_IN; d.Nsrc = INCOLS; d.K = 1024; d.kt = it % 16; d.ntile = it / 16; d.mode = 0; return d; }
  it -= I_IN;
  if (it < I_BR) { const int br = it / 128, r = it % 128; d.src = p.in[28 + br] + (size_t)l * 512 * 1024; d.dst = p.W + W_BR + (size_t)br * 1024 * 512; d.Nsrc = 1024; d.K = 512; d.kt = r % 8; d.ntile = r / 8; d.mode = 0; return d; }
  it -= I_BR;
  if (it < I_O) { d.src = p.in[31] + (size_t)l * 1024 * 1024; d.dst = p.W + W_O; d.Nsrc = 1024; d.K = 1024; d.kt = it % 16; d.ntile = it / 16; d.mode = 0; return d; }
  it -= I_O;
  if (it < I_GU) { d.src = p.in[32] + (size_t)l * 1024 * 2 * DFF; d.dst = p.W + W_GU; d.Nsrc = 2 * DFF; d.K = 1024; d.kt = it % 16; d.ntile = it / 16; d.mode = 1; return d; }
  it -= I_GU;
  d.src = p.in[33] + (size_t)l * DFF * 1024; d.dst = p.W + W_DN; d.Nsrc = 1024; d.K = DFF; d.kt = it % 44; d.ntile = it / 44; d.mode = 0; return d;
}

DEVI void wconv_load(const WDesc& d, int tid, f32x4 (&v)[2]) {
  const int kk = tid >> 4, n4 = (tid & 15) * 4;
  const int r = d.ntile * 64 + n4;
  int lcol;
  if (d.mode == 0) lcol = r;
  else { int t = r >> 8, w = (r >> 7) & 1, nn = (r >> 4) & 7, i = r & 15; lcol = (nn >= 4 ? DFF : 0) + t * 128 + w * 64 + (nn & 3) * 16 + i; }
#pragma unroll
  for (int h = 0; h < 2; ++h) {
    v[h] = (f32x4){0.f, 0.f, 0.f, 0.f};
    if (lcol < d.Nsrc) v[h] = *(const f32x4*)(d.src + (size_t)(d.kt * 64 + kk + h * 32) * d.Nsrc + lcol);
  }
}

DEVI void wconv_proc(const WDesc& d, int tid, const f32x4 (&v)[2], float* tile) {
  {
    const int kk = tid >> 4, n4 = (tid & 15) * 4;
#pragma unroll
    for (int h = 0; h < 2; ++h) {
      const int k = kk + h * 32;
      tile[k * 65 + n4 + 0] = v[h][0]; tile[k * 65 + n4 + 1] = v[h][1]; tile[k * 65 + n4 + 2] = v[h][2]; tile[k * 65 + n4 + 3] = v[h][3];
    }
  }
  __syncthreads();
  {
    const int n = tid >> 3, k8 = (tid & 7) * 8;
    u32x4 o;
    o[0] = pack2(tile[(k8 + 0) * 65 + n], tile[(k8 + 1) * 65 + n]);
    o[1] = pack2(tile[(k8 + 2) * 65 + n], tile[(k8 + 3) * 65 + n]);
    o[2] = pack2(tile[(k8 + 4) * 65 + n], tile[(k8 + 5) * 65 + n]);
    o[3] = pack2(tile[(k8 + 6) * 65 + n], tile[(k8 + 7) * 65 + n]);
    *(u32x4*)(d.dst + (size_t)(d.ntile * 64 + n) * d.K + d.kt * 64 + k8) = o;
  }
}

DEVI void phase_wconv(const Params& p, int l, char* smem) {
  constexpr int I_TOT = 16 * 132 + 3 * 8 * 16 + 16 * 16 + 16 * 88 + 44 * 16;
  const int tid = tidx();
  float* tiles = (float*)smem;
  int item = bidx();
  if (item >= I_TOT) return;
  WDesc d = wconv_desc(p, l, item);
  f32x4 v[2];
  wconv_load(d, tid, v);
  int par = 0;
  while (true) {
    const int next = item + gridDim.x;
    WDesc dn = d; f32x4 vn[2] = {v[0], v[1]};
    if (next < I_TOT) { dn = wconv_desc(p, l, next); wconv_load(dn, tid, vn); }
    wconv_proc(d, tid, v, tiles + par * (64 * 65));
    par ^= 1;
    if (next >= I_TOT) break;
    d = dn; v[0] = vn[0]; v[1] = vn[1]; item = next;
  }
  __syncthreads();
}

DEVI void phase_filters(const Params& p, int l, char* smem) {
  float* zf = (float*)smem;
  float* h1 = zf + 33 * 16;
  float* h2 = h1 + 64 * 16;
  const int tid = tidx();
  const float* w1 = p.in[11] + (size_t)l * 33 * 64;
  const float* b1 = p.in[12] + (size_t)l * 64;
  const float* w2 = p.in[13] + (size_t)l * 64 * 64;
  const float* b2 = p.in[14] + (size_t)l * 64;
  const float* w3 = p.in[15] + (size_t)l * 64 * 2048;
  const float* fr0 = p.in[16] + (size_t)l * 128;
  const float* fr1 = fr0 + 64;
  for (int item = bidx(); item < 144; item += gridDim.x) {
    const bool lat = item < 128;
    const int L = lat ? 2048 : 256;
    const int pos0 = lat ? item * 16 : (item - 128) * 16;
    __syncthreads();
    for (int idx = tid; idx < 33 * 16; idx += NT) {
      const int k = idx >> 4, i = idx & 15;
      const int pos = pos0 + i;
      float v;
      if (k == 0) v = (float)pos / (float)(L - 1);
      else {
        const int band = (k - 1) & 15;
        const float f = 1e-4f + (float)band * ((15.f - 1e-4f) / 15.f);
        const float w = 6.283185307179586f * (float)pos / (float)L;
        const float a = f * w;
        v = (k <= 16) ? __cosf(a) : -__sinf(a);
      }
      zf[k * 16 + i] = v;
    }
    __syncthreads();
    {
      const int i = tid & 15, j0 = (tid >> 4) * 2;
      float a0 = b1[j0], a1 = b1[j0 + 1];
#pragma unroll 11
      for (int k = 0; k < 33; ++k) { const float zv = zf[k * 16 + i]; a0 += zv * w1[k * 64 + j0]; a1 += zv * w1[k * 64 + j0 + 1]; }
      h1[j0 * 16 + i] = __sinf(fr0[j0] * a0); h1[(j0 + 1) * 16 + i] = __sinf(fr0[j0 + 1] * a1);
    }
    __syncthreads();
    {
      const int i = tid & 15, j0 = (tid >> 4) * 2;
      float a0 = b2[j0], a1 = b2[j0 + 1];
#pragma unroll 8
      for (int k = 0; k < 64; ++k) { const float hv = h1[k * 16 + i]; a0 += hv * w2[k * 64 + j0]; a1 += hv * w2[k * 64 + j0 + 1]; }
      h2[j0 * 16 + i] = __sinf(fr1[j0] * a0); h2[(j0 + 1) * 16 + i] = __sinf(fr1[j0 + 1] * a1);
    }
    __syncthreads();
    {
      const int col0 = tid * 4;
      f32x4 acc[16];
#pragma unroll
      for (int i = 0; i < 16; ++i) acc[i] = (f32x4){0.f, 0.f, 0.f, 0.f};
#pragma unroll 2
      for (int k = 0; k < 64; ++k) {
        const f32x4 wv = *(const f32x4*)(w3 + (size_t)k * 2048 + col0);
        const f32x4 ha = *(const f32x4*)(h2 + k * 16), hb = *(const f32x4*)(h2 + k * 16 + 4), hc = *(const f32x4*)(h2 + k * 16 + 8), hd = *(const f32x4*)(h2 + k * 16 + 12);
#pragma unroll
        for (int i = 0; i < 4; ++i) { acc[i] += wv * ha[i]; acc[4 + i] += wv * hb[i]; acc[8 + i] += wv * hc[i]; acc[12 + i] += wv * hd[i]; }
      }
      const int order = col0 >> 10, dir = (col0 >> 9) & 1, ch0 = col0 & 511;
#pragma unroll
      for (int j = 0; j < 4; ++j) {
        const int ch = ch0 + j;
        const float delta = 3.0701134573253945f + (float)ch * ((15.350567286626973f - 3.0701134573253945f) / 511.f);
        bf16_t* kg = lat ? (p.KG + KG_LAT + ((size_t)(order * 512 + ch)) * 4096) : (p.KG + KG_CTX + ((size_t)(order * 512 + ch)) * 512);
#pragma unroll
        for (int i = 0; i < 16; ++i) {
          const int pos = pos0 + i;
          const float tpos = (float)pos / (float)(L - 1);
          const float val = acc[i][j] * __expf(-tpos * delta);
          if (dir == 0) kg[L - pos] = f2bf(val);
          else { if (pos > 0) kg[L + pos] = f2bf(val); else kg[0] = 0; }
        }
      }
    }
  }
  __syncthreads();
}

DEVI void phase_norm(const Params& p, const float* xlat, const float* xctx, const float* nw, const float* modl, int shift_i, int scale_i, int ntok) {
  const int lane = tidx() & 63;
  const int gw = bidx() * (NT / 64) + (tidx() >> 6), nw_tot = gridDim.x * (NT / 64);
  for (int tok0 = gw; tok0 < ntok; tok0 += 2 * nw_tot) {
    const int tok1 = tok0 + nw_tot;
    const bool has1 = tok1 < ntok;
    const int tk[2] = {tok0, has1 ? tok1 : tok0};
    f32x4 v[2][4];
    float ss[2] = {0.f, 0.f};
#pragma unroll
    for (int u = 0; u < 2; ++u) {
      const int tok = tk[u];
      const float* xr = tok < NLAT ? xlat + (size_t)tok * D : xctx + (size_t)(tok - NLAT) * D;
#pragma unroll
      for (int i = 0; i < 4; ++i) v[u][i] = *(const f32x4*)(xr + i * 256 + lane * 4);
    }
#pragma unroll
    for (int u = 0; u < 2; ++u)
#pragma unroll
      for (int i = 0; i < 4; ++i) ss[u] += v[u][i][0] * v[u][i][0] + v[u][i][1] * v[u][i][1] + v[u][i][2] * v[u][i][2] + v[u][i][3] * v[u][i][3];
#pragma unroll
    for (int o = 32; o > 0; o >>= 1) { ss[0] += __shfl_xor(ss[0], o); ss[1] += __shfl_xor(ss[1], o); }
#pragma unroll
    for (int u = 0; u < 2; ++u) {
      if (u == 1 && !has1) break;
      const int tok = tk[u];
      const int r = tok < NLAT ? (tok >> 11) : 8;
      const float* sh = modl + (size_t)r * 6144 + shift_i * 1024;
      const float* sc = modl + (size_t)r * 6144 + scale_i * 1024;
      const float rstd = rsqrtf(ss[u] * (1.f / 1024.f) + EPS);
#pragma unroll
      for (int i = 0; i < 4; ++i) {
        const int c = i * 256 + lane * 4;
        f32x4 w = *(const f32x4*)(nw + c), s1 = *(const f32x4*)(sc + c), s0 = *(const f32x4*)(sh + c);
        float y0 = v[u][i][0] * rstd * w[0] * (1.f + s1[0]) + s0[0];
        float y1 = v[u][i][1] * rstd * w[1] * (1.f + s1[1]) + s0[1];
        float y2 = v[u][i][2] * rstd * w[2] * (1.f + s1[2]) + s0[2];
        float y3 = v[u][i][3] * rstd * w[3] * (1.f + s1[3]) + s0[3];
        u32x2 o = {pack2(y0, y1), pack2(y2, y3)};
        *(u32x2*)(p.H + (size_t)tok * D + c) = o;
      }
    }
  }
}

DEVI int swzf(int r2) { return (0x78 >> (2 * r2)) & 3; }

DEVI void wait_vmcnt(int n) {
  switch (n) {
    case 0: asm volatile("s_waitcnt vmcnt(0)" ::: "memory"); break;
    case 1: asm volatile("s_waitcnt vmcnt(1)" ::: "memory"); break;
    case 2: asm volatile("s_waitcnt vmcnt(2)" ::: "memory"); break;
    case 3: asm volatile("s_waitcnt vmcnt(3)" ::: "memory"); break;
    case 4: asm volatile("s_waitcnt vmcnt(4)" ::: "memory"); break;
    case 5: asm volatile("s_waitcnt vmcnt(5)" ::: "memory"); break;
    case 6: asm volatile("s_waitcnt vmcnt(6)" ::: "memory"); break;
    case 7: asm volatile("s_waitcnt vmcnt(7)" ::: "memory"); break;
    case 8: asm volatile("s_waitcnt vmcnt(8)" ::: "memory"); break;
    case 9: asm volatile("s_waitcnt vmcnt(9)" ::: "memory"); break;
    case 10: asm volatile("s_waitcnt vmcnt(10)" ::: "memory"); break;
    case 11: asm volatile("s_waitcnt vmcnt(11)" ::: "memory"); break;
    case 12: asm volatile("s_waitcnt vmcnt(12)" ::: "memory"); break;
    case 13: asm volatile("s_waitcnt vmcnt(13)" ::: "memory"); break;
    case 14: asm volatile("s_waitcnt vmcnt(14)" ::: "memory"); break;
    case 15: asm volatile("s_waitcnt vmcnt(15)" ::: "memory"); break;
    default: asm volatile("s_waitcnt vmcnt(16)" ::: "memory"); break;
  }
}
template <int MI, int NI, int NSTG = 2>
DEVI void gemm_mainloop(const bf16_t* __restrict__ A, int lda, const bf16_t* __restrict__ B, int ldb, int K, int m0, int n0,
                        char* smem, f32x4 (&acc)[MI][NI], bool pre_issued = false, bool has_next = false, int m0n = 0, int n0n = 0) {
  constexpr int BM = 64 * MI, BN = 32 * NI, STG = (BM + BN) * 128, NA = MI, NB = NI / 2, LPS = NA + NB;
  static_assert(NSTG * STG <= SMEM_BYTES, "LDS ring too large");
  static_assert((NSTG - 2) * LPS <= 16, "vmcnt switch range");
  const int tid = tidx(), lane = tid & 63, wid = tid >> 6, wr = wid >> 1, wc = wid & 1, fr = lane & 15, fq = lane >> 4;
  const bf16_t *ga, *gb;
  {
    const int row = tid >> 3, c = tid & 7;
    const int kc = c ^ ((row >> 1) & 7);
    ga = A + (size_t)(m0 + row) * lda + kc * 8;
    gb = B + (size_t)(n0 + row) * ldb + kc * 8;
  }
  const int nt = K >> 6;
  const int gsw = (fr >> 1) & 7;
  const int a_row = (wr * (16 * MI) + fr) * 128;
  const int b_row = BM * 128 + (wc * (16 * NI) + fr) * 128;
  auto stage = [&](int t) {
    char* sA = smem + (t % NSTG) * STG;
    const int ko = t * 64;
#pragma unroll
    for (int i = 0; i < NA; ++i)
      __builtin_amdgcn_global_load_lds((const unsigned*)(ga + (size_t)i * 64 * lda + ko), (__attribute__((address_space(3))) unsigned*)(sA + i * 8192 + tid * 16), 16, 0, 0);
#pragma unroll
    for (int i = 0; i < NB; ++i)
      __builtin_amdgcn_global_load_lds((const unsigned*)(gb + (size_t)i * 64 * ldb + ko), (__attribute__((address_space(3))) unsigned*)(sA + BM * 128 + i * 8192 + tid * 16), 16, 0, 0);
  };
  if (!pre_issued) {
    __syncthreads();
#pragma unroll
    for (int i = 0; i < NSTG - 1; ++i) if (i < nt) stage(i);
  }
  for (int t = 0; t < nt; ++t) {
    {
      const int rem = nt - 1 - t;
      const int ahead = rem < NSTG - 2 ? rem : NSTG - 2;
      wait_vmcnt(ahead * LPS);
    }
    __builtin_amdgcn_s_barrier();
    asm volatile("" ::: "memory");
    if (t + NSTG - 1 < nt) stage(t + NSTG - 1);
    else if (NSTG == 2 && has_next) {
      const int row = tid >> 3, c = tid & 7;
      const int kc = c ^ ((row >> 1) & 7);
      const bf16_t* gan = A + (size_t)(m0n + row) * lda + kc * 8;
      const bf16_t* gbn = B + (size_t)(n0n + row) * ldb + kc * 8;
#pragma unroll
      for (int i = 0; i < NA; ++i)
        __builtin_amdgcn_global_load_lds((const unsigned*)(gan + (size_t)i * 64 * lda), (__attribute__((address_space(3))) unsigned*)(smem + i * 8192 + tid * 16), 16, 0, 0);
#pragma unroll
      for (int i = 0; i < NB; ++i)
        __builtin_amdgcn_global_load_lds((const unsigned*)(gbn + (size_t)i * 64 * ldb), (__attribute__((address_space(3))) unsigned*)(smem + BM * 128 + i * 8192 + tid * 16), 16, 0, 0);
    }
    const char* sA = smem + (t % NSTG) * STG;
#pragma unroll
    for (int ks = 0; ks < 2; ++ks) {
      const int coff = ((fq + 4 * ks) ^ gsw) * 16;
      bf16x8 a[MI], b[NI];
#pragma unroll
      for (int mi = 0; mi < MI; ++mi) a[mi] = *(const bf16x8*)(sA + a_row + mi * 2048 + coff);
#pragma unroll
      for (int ni = 0; ni < NI; ++ni) b[ni] = *(const bf16x8*)(sA + b_row + ni * 2048 + coff);
      __builtin_amdgcn_s_setprio(1);
#pragma unroll
      for (int mi = 0; mi < MI; ++mi)
#pragma unroll
        for (int ni = 0; ni < NI; ++ni) acc[mi][ni] = __builtin_amdgcn_mfma_f32_16x16x32_bf16(b[ni], a[mi], acc[mi][ni], 0, 0, 0);
      __builtin_amdgcn_s_setprio(0);
    }
  }
}

template <int MI, int NI>
DEVI void zero_acc(f32x4 (&acc)[MI][NI]) {
#pragma unroll
  for (int i = 0; i < MI; ++i)
#pragma unroll
    for (int j = 0; j < NI; ++j) acc[i][j] = (f32x4){0.f, 0.f, 0.f, 0.f};
}

template <class F>
DEVI void for_tiles256(int nM, int nN, F f) {
  const int ntile = nM * nN;
  for (int T = bidx(); T < ntile; T += gridDim.x) {
    int tm, tn;
    if ((nM & 7) == 0) { tm = (T / (8 * nN)) * 8 + (T & 7); tn = (T % (8 * nN)) >> 3; }
    else { tm = T % nM; tn = T / nM; }
    f(tm, tn);
  }
}

template <class F>
DEVI void for_tiles(int nM, int nN, int PH, F f) {
  const int PW = 32 / PH;
  const int nPanM = (nM + PH - 1) / PH, nPanN = (nN + PW - 1) / PW, nchunks = nPanM * nPanN;
  const int cstride = gridDim.x >> 5;
  const int slot = bidx() / cstride;
  for (int chunk = bidx() % cstride; chunk < nchunks; chunk += cstride) {
    const int pm = chunk / nPanN, pn = chunk % nPanN;
    const int tm = pm * PH + (slot % PH), tn = pn * PW + (slot / PH);
    if (tm < nM && tn < nN) f(tm, tn);
  }
}

template <class F>
DEVI void for_tiles_la(int nM, int nN, int PH, F f) {
  const int PW = 32 / PH;
  const int nPanM = (nM + PH - 1) / PH, nPanN = (nN + PW - 1) / PW, nchunks = nPanM * nPanN;
  const int cstride = gridDim.x >> 5;
  const int slot = bidx() / cstride;
  auto tile_of = [&](int chunk, int& tm, int& tn) {
    const int pm = chunk / nPanN, pn = chunk % nPanN;
    tm = pm * PH + (slot % PH); tn = pn * PW + (slot / PH);
    return tm < nM && tn < nN;
  };
  int chunk = bidx() % cstride, tm = 0, tn = 0;
  while (chunk < nchunks && !tile_of(chunk, tm, tn)) chunk += cstride;
  bool pre = false;
  while (chunk < nchunks) {
    int nchunk = chunk + cstride, tmn = 0, tnn = 0;
    while (nchunk < nchunks && !tile_of(nchunk, tmn, tnn)) nchunk += cstride;
    const bool has_next = nchunk < nchunks;
    f(tm, tn, pre, has_next, tmn, tnn);
    pre = has_next; chunk = nchunk; tm = tmn; tn = tnn;
  }
}

template <int MI, int NI>
DEVI void epi_store_bf16(const f32x4 (&acc)[MI][NI], bf16_t* C, size_t ldc, int m0, int n0) {
  const int lane = tidx() & 63, wid = tidx() >> 6, wr = wid >> 1, wc = wid & 1, fr = lane & 15, fq = lane >> 4;
#pragma unroll
  for (int mi = 0; mi < MI; ++mi) {
    const int row = m0 + wr * (16 * MI) + mi * 16 + fr;
#pragma unroll
    for (int ni = 0; ni < NI; ++ni) {
      const int col = n0 + wc * (16 * NI) + ni * 16 + fq * 4;
      u32x2 o = {pack2(acc[mi][ni][0], acc[mi][ni][1]), pack2(acc[mi][ni][2], acc[mi][ni][3])};
      *(u32x2*)(C + (size_t)row * ldc + col) = o;
    }
  }
}

DEVI void phase_gemm_in(const Params& p, char* smem) {
  for_tiles_la(NTOK / 256, PLD / 256, 8, [&](int tm, int tn, bool pre, bool has_next, int tmn, int tnn) {
    f32x4 acc[4][8]; zero_acc<4, 8>(acc);
    gemm_mainloop<4, 8, 2>(p.H, 1024, p.W + W_IN + (size_t)HYC * 1024, 1024, 1024, tm * 256, tn * 256, smem, acc, pre, has_next, tmn * 256, tnn * 256);
    epi_store_bf16<4, 8>(acc, p.P, PLD, tm * 256, tn * 256);
  });
  for_tiles_la(HYC / 256, NTOK / 256, 2, [&](int tm, int tn, bool pre, bool has_next, int tmn, int tnn) {
    f32x4 acc[4][8]; zero_acc<4, 8>(acc);
    gemm_mainloop<4, 8, 2>(p.W + W_IN, 1024, p.H, 1024, 1024, tm * 256, tn * 256, smem, acc, pre, has_next, tmn * 256, tnn * 256);
    epi_store_bf16<4, 8>(acc, p.PT, NTOK, tm * 256, tn * 256);
  });
}

DEVI void phase_gemm_merge(const Params& p, int ntok, char* smem) {
  const bf16_t* YS = p.PT + (size_t)512 * NTOK;
  const bf16_t* YG = p.PT + (size_t)1024 * NTOK;
  for_tiles(ntok / 128, D / 128, 4, [&](int tm, int tn) {
    const int m0 = tm * 128, n0 = tn * 128;
    const int lane = tidx() & 63, wid = tidx() >> 6, wr = wid >> 1, wc = wid & 1, fr = lane & 15, fq = lane >> 4;
    f32x4 tot[2][4]; zero_acc<2, 4>(tot);
#pragma unroll 1
    for (int br = 0; br < 3; ++br) {
      f32x4 acc[2][4]; zero_acc<2, 4>(acc);
      const bf16_t* A = br == 0 ? p.YH : (br == 1 ? YS : YG);
      gemm_mainloop<2, 4, 3>(A, 512, p.W + W_BR + (size_t)br * 1024 * 512, 512, 512, m0, n0, smem, acc);
#pragma unroll
      for (int mi = 0; mi < 2; ++mi) {
        const int row = m0 + wr * 32 + mi * 16 + fr;
#pragma unroll
        for (int ni = 0; ni < 4; ++ni) {
          const int col = n0 + wc * 64 + ni * 16 + fq * 4;
          u32x2 g = *(const u32x2*)(p.P + (size_t)row * PLD + PC_GATE + br * 1024 + col);
          tot[mi][ni][0] += sigmoid_f(lo2f(g[0])) * acc[mi][ni][0];
          tot[mi][ni][1] += sigmoid_f(hi2f(g[0])) * acc[mi][ni][1];
          tot[mi][ni][2] += sigmoid_f(lo2f(g[1])) * acc[mi][ni][2];
          tot[mi][ni][3] += sigmoid_f(hi2f(g[1])) * acc[mi][ni][3];
        }
      }
    }
#pragma unroll
    for (int mi = 0; mi < 2; ++mi) {
      const int row = m0 + wr * 32 + mi * 16 + fr;
#pragma unroll
      for (int ni = 0; ni < 4; ++ni) {
        const int col = n0 + wc * 64 + ni * 16 + fq * 4;
        u32x2 o = {pack2(tot[mi][ni][0], tot[mi][ni][1]), pack2(tot[mi][ni][2], tot[mi][ni][3])};
        *(u32x2*)(p.H + (size_t)row * D + col) = o;
      }
    }
  });
}

DEVI void phase_gemm_resid(const Params& p, const bf16_t* A, int lda, const bf16_t* Bt, int K, int ntok,
                           const float* xin_lat, const float* xin_ctx, const float* modl, int gate_i, char* smem) {
  for_tiles(ntok / 256, D / 128, 4, [&](int tm, int tn) {
    const int m0 = tm * 256, n0 = tn * 128;
    const int lane = tidx() & 63, wid = tidx() >> 6, wr = wid >> 1, wc = wid & 1, fr = lane & 15, fq = lane >> 4;
    f32x4 acc[4][4]; zero_acc<4, 4>(acc);
    gemm_mainloop<4, 4, 3>(A, lda, Bt, K, K, m0, n0, smem, acc);
    const int r = m0 < NLAT ? (m0 >> 11) : 8;
    const float* gate = modl + (size_t)r * 6144 + gate_i * 1024;
#pragma unroll
    for (int mi = 0; mi < 4; ++mi) {
      const int row = m0 + wr * 64 + mi * 16 + fr;
      const float* xi = row < NLAT ? xin_lat + (size_t)row * D : xin_ctx + (size_t)(row - NLAT) * D;
      float* xo = row < NLAT ? p.out + (size_t)row * D : p.xctx + (size_t)(row - NLAT) * D;
#pragma unroll
      for (int ni = 0; ni < 4; ++ni) {
        const int col = n0 + wc * 64 + ni * 16 + fq * 4;
        f32x4 xv = *(const f32x4*)(xi + col), gv = *(const f32x4*)(gate + col);
        f32x4 o;
        o[0] = xv[0] + gv[0] * acc[mi][ni][0]; o[1] = xv[1] + gv[1] * acc[mi][ni][1];
        o[2] = xv[2] + gv[2] * acc[mi][ni][2]; o[3] = xv[3] + gv[3] * acc[mi][ni][3];
        *(f32x4*)(xo + col) = o;
      }
    }
  });
}

DEVI void phase_gemm_gateup(const Params& p, int ntok, char* smem) {
  bf16_t* hid = p.P;
  for_tiles_la(ntok / 256, (2 * DFF) / 256, 8, [&](int tm, int tn, bool pre, bool has_next, int tmn, int tnn) {
    const int m0 = tm * 256, n0 = tn * 256;
    const int lane = tidx() & 63, wid = tidx() >> 6, wr = wid >> 1, wc = wid & 1, fr = lane & 15, fq = lane >> 4;
    f32x4 acc[4][8]; zero_acc<4, 8>(acc);
    gemm_mainloop<4, 8, 2>(p.H, 1024, p.W + W_GU, 1024, 1024, m0, n0, smem, acc, pre, has_next, tmn * 256, tnn * 256);
#pragma unroll
    for (int mi = 0; mi < 4; ++mi) {
      const int row = m0 + wr * 64 + mi * 16 + fr;
#pragma unroll
      for (int ni = 0; ni < 4; ++ni) {
        const int col = tn * 128 + wc * 64 + ni * 16 + fq * 4;
        f32x4 g = acc[mi][ni], u = acc[mi][ni + 4];
        u32x2 o = {pack2(silu_f(g[0]) * u[0], silu_f(g[1]) * u[1]), pack2(silu_f(g[2]) * u[2], silu_f(g[3]) * u[3])};
        *(u32x2*)(hid + (size_t)row * DFF + col) = o;
      }
    }
  });
}

DEVI void conv4_T(const bf16_t* __restrict__ row, int tb, int t, int L, bool lat, float w0, float w1, float w2, float bias, float (&out)[4]) {
  u32x2 mid = *(const u32x2*)(row + tb + t);
  float r[6];
  r[1] = lo2f(mid[0]); r[2] = hi2f(mid[0]); r[3] = lo2f(mid[1]); r[4] = hi2f(mid[1]);
  const bool lv = lat ? ((t & 63) != 0) : (t != 0);
  const bool rv = lat ? (((t + 4) & 63) != 0) : (t + 4 < L);
  r[0] = lv ? bf2f(row[tb + t - 1]) : 0.f;
  r[5] = rv ? bf2f(row[tb + t + 4]) : 0.f;
#pragma unroll
  for (int i = 0; i < 4; ++i) out[i] = w0 * r[i] + w1 * r[i + 1] + w2 * r[i + 2] + bias;
}

template <int L>
DEVI void hyena_channel(const Params& p, int l, int c, char* smem) {
  constexpr bool LAT = (L == 2048);
  constexpr int USTRIDE = (L + 32) * 2;
  constexpr int KCSTRIDE = (2 * L + 16) * 2 + 16;
  constexpr int NJ = 2 * L + 16;
  constexpr int NGI = L / 256;
  char* U = smem;
  char* KC = smem + 8 * USTRIDE;
  const int tid = tidx(), lane = tid & 63, wid = tid >> 6, fr = lane & 15, fq = lane >> 4;
  const int tok0 = LAT ? 0 : NLAT;
  const float* cw = p.in[9] + (size_t)l * 3 * HYC;
  const float* cbias = p.in[10] + (size_t)l * HYC;
  const float* hb = p.in[17] + (size_t)l * 2 * 512;
  const bf16_t* rowv = p.PT + (size_t)c * NTOK;
  const bf16_t* rowx1 = p.PT + (size_t)(512 + c) * NTOK;
  const bf16_t* rowx2 = p.PT + (size_t)(1024 + c) * NTOK;
  bf16_t* rowo = p.PT + (size_t)c * NTOK;
  const bf16_t* kg0 = LAT ? (p.KG + KG_LAT + (size_t)c * 4096) : (p.KG + KG_CTX + (size_t)c * 512);
  const bf16_t* kg1 = LAT ? (p.KG + KG_LAT + (size_t)(512 + c) * 4096) : (p.KG + KG_CTX + (size_t)(512 + c) * 512);

  __syncthreads();
  {
    const float w0 = cw[c], w1 = cw[HYC + c], w2 = cw[2 * HYC + c], bs = cbias[c];
#pragma unroll 4
    for (int u = tid; u < 8 * L / 4; u += NT) {
      const int b = u / (L / 4), t = (u % (L / 4)) * 4;
      float o[4];
      conv4_T(rowv, tok0 + b * L, t, L, LAT, w0, w1, w2, bs, o);
      u32x2 pk = {pack2(o[0], o[1]), pack2(o[2], o[3])};
      *(u32x2*)(U + b * USTRIDE + t * 2) = pk;
    }
  }
  unsigned* KRraw = (unsigned*)(KC + 8 * KCSTRIDE);
  auto load_kr = [&](const bf16_t* kg) {
    if (tid < 2 * L / 8) *(u32x4*)(KRraw + 4 + tid * 4) = *(const u32x4*)(kg + tid * 8);
    if (tid < 4) { KRraw[tid] = 0u; }
    if (tid >= 4 && tid < 16) { KRraw[L + 4 + (tid - 4)] = 0u; }
  };
  auto build_kc = [&]() {
#pragma unroll 4
    for (int u = tid; u < 8 * (NJ / 2); u += NT) {
      const int s = u / (NJ / 2), jp = u % (NJ / 2);
      const int e0 = 2 * jp + s;
      const unsigned w0 = KRraw[e0 >> 1], w1 = KRraw[(e0 >> 1) + 1];
      const unsigned val = (e0 & 1) ? __builtin_amdgcn_alignbit(w1, w0, 16) : w0;
      *(unsigned*)(KC + s * KCSTRIDE + jp * 4) = val;
    }
  };
  load_kr(kg0);
  __syncthreads();
  build_kc();
  __syncthreads();

  const int sshift = (8 - (fr & 7)) & 7;
  const int c0 = fq - ((fr + sshift) >> 3);
  const char* kc_base = KC + sshift * KCSTRIDE;
  const int ib = fr >> 3, bb = fr & 7;
  const char* u_base = U + bb * USTRIDE;

  f32x4 acc[NGI];
  auto conv_loop = [&]() {
#pragma unroll
    for (int gi = 0; gi < NGI; ++gi) acc[gi] = (f32x4){0.f, 0.f, 0.f, 0.f};
    for (int dd = wid - (L / 32 - 1); dd <= wid + 8 * (NGI - 1) + 1; ++dd) {
      int qpos = L / 8 - 4 * dd + c0 + 1;
      qpos = qpos < 0 ? 0 : (qpos > 2 * L / 8 + 1 ? 2 * L / 8 + 1 : qpos);
      const bf16x8 tf = *(const bf16x8*)(kc_base + qpos * 16);
      bf16x8 uf[NGI];
#pragma unroll
      for (int gi = 0; gi < NGI; ++gi) {
        const int s = 32 * (wid + 8 * gi - dd) + 16 * ib + 8 * fq;
        const bool valid = (s >= 0) && (s < L);
        const int sc = valid ? s : 0;
        uf[gi] = *(const bf16x8*)(u_base + sc * 2);
        if (!valid) uf[gi] = (bf16x8){0, 0, 0, 0, 0, 0, 0, 0};
      }
#pragma unroll
      for (int gi = 0; gi < NGI; ++gi) acc[gi] = __builtin_amdgcn_mfma_f32_16x16x32_bf16(tf, uf[gi], acc[gi], 0, 0, 0);
    }
  };
  conv_loop();
  u32x2 zpk[NGI];
  {
    const float w0 = cw[512 + c], w1 = cw[HYC + 512 + c], w2 = cw[2 * HYC + 512 + c], bs = cbias[512 + c];
    const float hb0 = hb[c];
#pragma unroll
    for (int gi = 0; gi < NGI; ++gi) {
      const int g = wid + 8 * gi;
      const int t = 32 * g + 16 * ib + fq * 4;
      float x1[4];
      conv4_T(rowx1, tok0 + bb * L, t, L, LAT, w0, w1, w2, bs, x1);
      u32x2 vv = *(const u32x2*)(u_base + t * 2);
      float z0 = x1[0] * (acc[gi][0] + hb0 * lo2f(vv[0]));
      float z1 = x1[1] * (acc[gi][1] + hb0 * hi2f(vv[0]));
      float z2 = x1[2] * (acc[gi][2] + hb0 * lo2f(vv[1]));
      float z3 = x1[3] * (acc[gi][3] + hb0 * hi2f(vv[1]));
      zpk[gi] = (u32x2){pack2(z0, z1), pack2(z2, z3)};
    }
  }
  __syncthreads();
#pragma unroll
  for (int gi = 0; gi < NGI; ++gi) {
    const int g = wid + 8 * gi;
    const int t = 32 * g + 16 * ib + fq * 4;
    *(u32x2*)(U + bb * USTRIDE + t * 2) = zpk[gi];
  }
  load_kr(kg1);
  __syncthreads();
  build_kc();
  __syncthreads();
  conv_loop();
  {
    const float w0 = cw[1024 + c], w1 = cw[HYC + 1024 + c], w2 = cw[2 * HYC + 1024 + c], bs = cbias[1024 + c];
    const float hb1 = hb[512 + c];
#pragma unroll
    for (int gi = 0; gi < NGI; ++gi) {
      const int g = wid + 8 * gi;
      const int t = 32 * g + 16 * ib + fq * 4;
      float x2[4];
      conv4_T(rowx2, tok0 + bb * L, t, L, LAT, w0, w1, w2, bs, x2);
      float y0 = x2[0] * (acc[gi][0] + hb1 * lo2f(zpk[gi][0]));
      float y1 = x2[1] * (acc[gi][1] + hb1 * hi2f(zpk[gi][0]));
      float y2 = x2[2] * (acc[gi][2] + hb1 * lo2f(zpk[gi][1]));
      float y3 = x2[3] * (acc[gi][3] + hb1 * hi2f(zpk[gi][1]));
      u32x2 o = {pack2(y0, y1), pack2(y2, y3)};
      *(u32x2*)(rowo + tok0 + bb * L + t) = o;
    }
  }
  __syncthreads();
}

DEVI void conv4_P(const bf16_t* __restrict__ P, int tok, bool lv, bool rv, int col, const float* __restrict__ cw, int cstride, int cc,
                  const float* __restrict__ cb, float (&out)[4]) {
  const bf16_t* q = P + (size_t)tok * PLD + col;
  u32x2 m = *(const u32x2*)q;
  u32x2 a = {0u, 0u}, b = {0u, 0u};
  if (lv) a = *(const u32x2*)(q - PLD);
  if (rv) b = *(const u32x2*)(q + PLD);
  f32x4 w0 = *(const f32x4*)(cw + cc), w1 = *(const f32x4*)(cw + cstride + cc), w2 = *(const f32x4*)(cw + 2 * cstride + cc);
  f32x4 bs = {0.f, 0.f, 0.f, 0.f};
  if (cb) bs = *(const f32x4*)(cb + cc);
  out[0] = w0[0] * lo2f(a[0]) + w1[0] * lo2f(m[0]) + w2[0] * lo2f(b[0]) + bs[0];
  out[1] = w0[1] * hi2f(a[0]) + w1[1] * hi2f(m[0]) + w2[1] * hi2f(b[0]) + bs[1];
  out[2] = w0[2] * lo2f(a[1]) + w1[2] * lo2f(m[1]) + w2[2] * lo2f(b[1]) + bs[2];
  out[3] = w0[3] * hi2f(a[1]) + w1[3] * hi2f(m[1]) + w2[3] * hi2f(b[1]) + bs[3];
}

typedef float f32x2 __attribute__((ext_vector_type(2)));
DEVI float dpp_f(float v, const int ctrl_sel) {
  int r;
  if (ctrl_sel == 0) r = __builtin_amdgcn_update_dpp(0, __float_as_int(v), 0xB1, 0xf, 0xf, true);
  else if (ctrl_sel == 1) r = __builtin_amdgcn_update_dpp(0, __float_as_int(v), 0x4E, 0xf, 0xf, true);
  else r = __builtin_amdgcn_update_dpp(0, __float_as_int(v), 0x141, 0xf, 0xf, true);
  return __int_as_float(r);
}
DEVI float red8(float v) { v += dpp_f(v, 0); v += dpp_f(v, 1); v += dpp_f(v, 2); return v; }

template <class ColF>
DEVI void scan_load_raw(const bf16_t* __restrict__ P, int tb, int L, bool lat, int dir, int ci, int tid, ColF colf,
                        u32x2 (&m)[5], u32x2 (&a)[5], u32x2 (&b)[5]) {
#pragma unroll
  for (int k = 0; k < 5; ++k) {
    const int u = tid + k * NT;
    const int j = u / 80, qd = u % 80;
    const int t = dir == 0 ? ci * 32 + j : L - 1 - (ci * 32 + j);
    const bool lv = lat ? ((t & 63) != 0) : (t != 0);
    const bool rv = lat ? ((t & 63) != 63) : (t != L - 1);
    const bf16_t* q = P + (size_t)(tb + t) * PLD + colf(qd);
    m[k] = *(const u32x2*)q;
    a[k] = (u32x2){0u, 0u}; b[k] = (u32x2){0u, 0u};
    if (lv) a[k] = *(const u32x2*)(q - PLD);
    if (rv) b[k] = *(const u32x2*)(q + PLD);
  }
}
DEVI f32x4 scan_conv_quad(const float* wt, int qd, u32x2 m, u32x2 a, u32x2 b) {
  const f32x4 w0 = *(const f32x4*)(wt + qd * 16), w1 = *(const f32x4*)(wt + qd * 16 + 4), w2 = *(const f32x4*)(wt + qd * 16 + 8),
              bs = *(const f32x4*)(wt + qd * 16 + 12);
  f32x4 o;
  o[0] = silu_f(w0[0] * lo2f(a[0]) + w1[0] * lo2f(m[0]) + w2[0] * lo2f(b[0]) + bs[0]);
  o[1] = silu_f(w0[1] * hi2f(a[0]) + w1[1] * hi2f(m[0]) + w2[1] * hi2f(b[0]) + bs[1]);
  o[2] = silu_f(w0[2] * lo2f(a[1]) + w1[2] * lo2f(m[1]) + w2[2] * lo2f(b[1]) + bs[2]);
  o[3] = silu_f(w0[3] * hi2f(a[1]) + w1[3] * hi2f(m[1]) + w2[3] * hi2f(b[1]) + bs[3]);
  return o;
}

DEVI void lds_barrier() { asm volatile("s_waitcnt lgkmcnt(0)\n\ts_barrier" ::: "memory"); }
DEVI void phase_act(const Params& p, int l) {
  const int lane = tidx() & 63;
  const int gw = bidx() * (NT / 64) + (tidx() >> 6), nw_tot = gridDim.x * (NT / 64);
  const float* scw = p.in[18] + (size_t)l * 3 * 1024;
  const float* scb = p.in[19] + (size_t)l * 1024;
  const float* gcw = p.in[24] + (size_t)l * 3 * 1536;
  const bool ctxw = gw < 160;
  for (int task = ctxw ? gw : gw - 160; task < (ctxw ? 160 : 5120); task += (ctxw ? 160 : nw_tot - 160)) {
    const int rowi = ctxw ? task / 20 : 8 + task / 20, slab = task % 20;
    int tok0, len;
    if (rowi < 8) { tok0 = NLAT + rowi * CTXL; len = CTXL; } else { tok0 = (rowi - 8) * 64; len = 64; }
    const bool ssm = slab < 8;
    const int cc = (ssm ? slab * 128 : (slab - 8) * 128) + lane * 2;
    const int col = (ssm ? PC_SSM + 512 : PC_GDN) + cc;
    const int nrm = ssm ? 0 : (slab - 8 < 4 ? 1 : (slab - 8 < 8 ? 2 : 0));
    float w0a, w0b, w1a, w1b, w2a, w2b, ba = 0.f, bb = 0.f;
    if (ssm) { w0a = scw[cc]; w0b = scw[cc + 1]; w1a = scw[1024 + cc]; w1b = scw[1024 + cc + 1]; w2a = scw[2048 + cc]; w2b = scw[2048 + cc + 1]; ba = scb[cc]; bb = scb[cc + 1]; }
    else { w0a = gcw[cc]; w0b = gcw[cc + 1]; w1a = gcw[1536 + cc]; w1b = gcw[1536 + cc + 1]; w2a = gcw[3072 + cc]; w2b = gcw[3072 + cc + 1]; }
    unsigned* base = (unsigned*)(p.P + (size_t)tok0 * PLD + col);
    constexpr int RS = PLD / 2;
    unsigned prev = 0u;
    unsigned r[9], rn[8];
#pragma unroll
    for (int i = 0; i < 9; ++i) r[i] = base[(size_t)i * RS];
    for (int t0 = 0; t0 < len; t0 += 8) {
#pragma unroll
      for (int i = 0; i < 8; ++i) {
        const int tt = t0 + 9 + i;
        const bool ok = tt < len;
        const unsigned v = base[(size_t)(ok ? tt : len - 1) * RS];
        rn[i] = ok ? v : 0u;
      }
      float ya[8], yb[8];
#pragma unroll
      for (int i = 0; i < 8; ++i) {
        const unsigned xm = i == 0 ? prev : r[i - 1], xc = r[i], xp = r[i + 1];
        ya[i] = silu_f(w0a * lo2f(xm) + w1a * lo2f(xc) + w2a * lo2f(xp) + ba);
        yb[i] = silu_f(w0b * hi2f(xm) + w1b * hi2f(xc) + w2b * hi2f(xp) + bb);
      }
      if (nrm) {
        float ss[8];
#pragma unroll
        for (int i = 0; i < 8; ++i) ss[i] = ya[i] * ya[i] + yb[i] * yb[i];
#pragma unroll
        for (int o = 32; o > 0; o >>= 1)
#pragma unroll
          for (int i = 0; i < 8; ++i) ss[i] += __shfl_xor(ss[i], o);
#pragma unroll
        for (int i = 0; i < 8; ++i) {
          const float sc = rsqrtf(ss[i] + EPS) * (nrm == 1 ? 0.08838834764831845f : 1.f);
          ya[i] *= sc; yb[i] *= sc;
        }
      }
#pragma unroll
      for (int i = 0; i < 8; ++i) base[(size_t)(t0 + i) * RS] = pack2(ya[i], yb[i]);
      prev = r[7]; r[0] = r[8];
#pragma unroll
      for (int i = 0; i < 8; ++i) r[i + 1] = rn[i];
    }
  }
}

DEVI bf16x8 ldsfrag(const bf16_t* base, int row, int stride_el, int kel) { return *(const bf16x8*)(base + row * stride_el + kel); }

DEVI void ssd_chain(const Params& p, int l, int item, char* smem) {
  const int b = item >> 4, e = (item >> 1) & 7, dir = item & 1, g = e >> 2;
  const int tid = tidx(), lane = tid & 63, wid = tid >> 6, fr = lane & 15, fq = lane >> 4;
  float* wt = (float*)smem;
  float* dts = wt + 1280;
  float* acs = dts + 64;
  bf16_t* Bn = (bf16_t*)(acs + 64);
  bf16_t* Cn = Bn + 64 * 136;
  bf16_t* Hb = Cn + 64 * 136;
  bf16_t* BwT = Hb + 64 * 136;
  bf16_t* XdT = BwT + 128 * 72;
  bf16_t* Xn = XdT + 64 * 72;
  bf16_t* Mm = Xn + 64 * 72;
  const float* cw = p.in[18] + (size_t)l * 3 * 1024;
  const float* cb = p.in[19] + (size_t)l * 1024;
  const float dtb = p.in[20][l * 16 + dir * 8 + e];
  const float Aneg = -__expf(p.in[21][l * 16 + dir * 8 + e]);
  const float Dsk = dir == 0 ? p.in[22][l * 8 + e] : 0.f;
  bf16_t* Yout = p.H + (size_t)dir * NTOK * 512;
  auto ccof = [&](int qd) { return qd < 16 ? e * 64 + qd * 4 : (qd < 48 ? 512 + g * 128 + (qd - 16) * 4 : 768 + g * 128 + (qd - 48) * 4); };
  lds_barrier();
  for (int i = tid; i < 64 * 136 / 2; i += NT) ((unsigned*)Hb)[i] = 0u;
  u32x2 rm[5];
  float rdt = 0.f;
  auto seg_of = [&](int c, int& L, int& tb, bool& lat, int& ci) {
    if (c < 4) { L = CTXL; tb = NLAT + b * CTXL; lat = false; ci = c; } else { L = SEQ; tb = b * SEQ; lat = true; ci = c - 4; }
  };
  auto do_load = [&](int c, int kb) {
    int L, tb, ci; bool lat; seg_of(c, L, tb, lat, ci);
    int tidl = tid; asm volatile("" : "+v"(tidl));
    int rj_ = (tidl + kb * NT) / 80, rq_ = (tidl + kb * NT) - rj_ * 80;
#pragma unroll
    for (int k = 0; k < 5; ++k) {
      const int j = rj_, qd = rq_;
      rq_ += 32; rj_ += 6; if (rq_ >= 80) { rq_ -= 80; rj_ += 1; }
      const int t = dir == 0 ? ci * 64 + j : L - 1 - (ci * 64 + j);
      rm[k] = *(const u32x2*)(p.P + (size_t)(tb + t) * PLD + PC_SSM + 512 + ccof(qd));
    }
    if (kb == 0 && tid < 64) { const int t = dir == 0 ? ci * 64 + tid : L - 1 - (ci * 64 + tid); rdt = bf2f(p.P[(size_t)(tb + t) * PLD + PC_SSM + 1536 + dir * 8 + e]); }
  };
  auto do_dt = [&]() {
    if (tid < 64) {
      const float dt = softplus_f(rdt + dtb);
      float a = dt * Aneg;
#pragma unroll
      for (int o = 1; o < 64; o <<= 1) { const float v = __shfl_up(a, o); if (lane >= o) a += v; }
      dts[tid] = dt; acs[tid] = a;
    }
  };
  auto do_convert = [&](int kb) {
    const float alast = acs[63];
    int tidl = tid; asm volatile("" : "+v"(tidl));
    int rj_ = (tidl + kb * NT) / 80, rq_ = (tidl + kb * NT) - rj_ * 80;
#pragma unroll
    for (int k = 0; k < 5; ++k) {
      const int s = rj_, qd = rq_;
      rq_ += 32; rj_ += 6; if (rq_ >= 80) { rq_ -= 80; rj_ += 1; }
      const u32x2 pk = rm[k];
      const f32x4 o = {lo2f(pk[0]), hi2f(pk[0]), lo2f(pk[1]), hi2f(pk[1])};
      if (qd < 16) {
        const int p0 = qd * 4;
        *(u32x2*)(Xn + s * 72 + p0) = pk;
        const float dt = dts[s];
#pragma unroll
        for (int i = 0; i < 4; ++i) XdT[(p0 + i) * 72 + s] = f2bf(o[i] * dt);
      } else if (qd < 48) {
        const int n0 = (qd - 16) * 4;
        *(u32x2*)(Bn + s * 136 + n0) = pk;
        const float w = __expf(alast - acs[s]);
#pragma unroll
        for (int i = 0; i < 4; ++i) BwT[(n0 + i) * 72 + s] = f2bf(o[i] * w);
      } else {
        const int n0 = (qd - 48) * 4;
        *(u32x2*)(Cn + s * 136 + n0) = pk;
      }
    }
  };
  f32x4 Hacc[4];
#pragma unroll
  for (int i = 0; i < 4; ++i) Hacc[i] = (f32x4){0.f, 0.f, 0.f, 0.f};
  do_load(0, 0);
  do_dt();
  lds_barrier();
  do_convert(0);
  do_load(0, 5);
  do_convert(5);
  lds_barrier();
  for (int c = 0; c < 36; ++c) {
    if (c + 1 < 36) do_load(c + 1, 0);
#pragma unroll
    for (int h = 0; h < 2; ++h) {
      const int tt = wid + 8 * h, tl = tt >> 2, ts = tt & 3;
      f32x4 gacc = {0.f, 0.f, 0.f, 0.f};
      if (ts <= tl) {
#pragma unroll
        for (int kk = 0; kk < 4; ++kk)
          gacc = __builtin_amdgcn_mfma_f32_16x16x32_bf16(ldsfrag(Cn, tl * 16 + fr, 136, kk * 32 + fq * 8), ldsfrag(Bn, ts * 16 + fr, 136, kk * 32 + fq * 8), gacc, 0, 0, 0);
      }
      const int scol = ts * 16 + fr;
      const float as = acs[scol];
#pragma unroll
      for (int jj = 0; jj < 4; ++jj) {
        const int lrow = tl * 16 + fq * 4 + jj;
        const float val = (scol <= lrow) ? gacc[jj] * __expf(acs[lrow] - as) : 0.f;
        Mm[lrow * 72 + scol] = f2bf(val);
      }
    }
    lds_barrier();
    {
      int L, tb, ci; bool lat; seg_of(c, L, tb, lat, ci);
#pragma unroll
      for (int h = 0; h < 2; ++h) {
        const int tt = wid + 8 * h, tp = tt >> 2, tl = tt & 3;
        f32x4 acc = {0.f, 0.f, 0.f, 0.f};
#pragma unroll
        for (int kk = 0; kk < 4; ++kk)
          acc = __builtin_amdgcn_mfma_f32_16x16x32_bf16(ldsfrag(Hb, tp * 16 + fr, 136, kk * 32 + fq * 8), ldsfrag(Cn, tl * 16 + fr, 136, kk * 32 + fq * 8), acc, 0, 0, 0);
        const int lrow = tl * 16 + fr;
        const float sc = __expf(acs[lrow]);
        acc[0] *= sc; acc[1] *= sc; acc[2] *= sc; acc[3] *= sc;
#pragma unroll
        for (int kk = 0; kk < 2; ++kk)
          acc = __builtin_amdgcn_mfma_f32_16x16x32_bf16(ldsfrag(XdT, tp * 16 + fr, 72, kk * 32 + fq * 8), ldsfrag(Mm, tl * 16 + fr, 72, kk * 32 + fq * 8), acc, 0, 0, 0);
        const int p0 = tp * 16 + fq * 4;
        const u32x2 xv = *(const u32x2*)(Xn + lrow * 72 + p0);
        const float y0 = acc[0] + Dsk * lo2f(xv[0]), y1 = acc[1] + Dsk * hi2f(xv[0]), y2 = acc[2] + Dsk * lo2f(xv[1]), y3 = acc[3] + Dsk * hi2f(xv[1]);
        const int t = dir == 0 ? ci * 64 + lrow : L - 1 - (ci * 64 + lrow);
        const u32x2 o = {pack2(y0, y1), pack2(y2, y3)};
        *(u32x2*)(Yout + (size_t)(tb + t) * 512 + e * 64 + p0) = o;
      }
    }
    {
      const float ea = __expf(acs[63]);
#pragma unroll
      for (int tp = 0; tp < 4; ++tp) {
        Hacc[tp][0] *= ea; Hacc[tp][1] *= ea; Hacc[tp][2] *= ea; Hacc[tp][3] *= ea;
#pragma unroll
        for (int kk = 0; kk < 2; ++kk)
          Hacc[tp] = __builtin_amdgcn_mfma_f32_16x16x32_bf16(ldsfrag(BwT, wid * 16 + fr, 72, kk * 32 + fq * 8), ldsfrag(XdT, tp * 16 + fr, 72, kk * 32 + fq * 8), Hacc[tp], 0, 0, 0);
      }
    }
    lds_barrier();
#pragma unroll
    for (int tp = 0; tp < 4; ++tp) {
      const u32x2 o = {pack2(Hacc[tp][0], Hacc[tp][1]), pack2(Hacc[tp][2], Hacc[tp][3])};
      *(u32x2*)(Hb + (tp * 16 + fr) * 136 + wid * 16 + fq * 4) = o;
    }
    if (c + 1 < 36) do_dt();
    lds_barrier();
    if (c + 1 < 36) { do_convert(0); do_load(c + 1, 5); do_convert(5); }
    lds_barrier();
  }
}

template <int STRIDE>
DEVI bf16x8 trfrag(const bf16_t* base, int k0, int c0, int fr, int fq) {
  const unsigned addr = (unsigned)(size_t)(base + (k0 + fq * 8 + (fr >> 2)) * STRIDE + c0 + 4 * (fr & 3));
  u32x2 lo, hi;
  asm volatile("ds_read_b64_tr_b16 %0, %2\n\tds_read_b64_tr_b16 %1, %2 offset:%3\n\ts_waitcnt lgkmcnt(0)" : "=&v"(lo), "=&v"(hi) : "v"(addr), "i"(8 * STRIDE) : "memory");
  u32x4 r = {lo[0], lo[1], hi[0], hi[1]};
  return __builtin_bit_cast(bf16x8, r);
}
DEVI void gdn_chain(const Params& p, int l, int item, char* smem) {
  const int b = item >> 4, hh = (item >> 2) & 3, dir = (item >> 1) & 1, vh = item & 1;
  const int tid = tidx(), lane = tid & 63, wid = tid >> 6, fr = lane & 15, fq = lane >> 4;
  float* wt = (float*)smem;
  float* gcs = wt + 1280;
  float* bts = gcs + 64;
  float* Af = bts + 64;
  float* UT = Af + 64 * 68;
  bf16_t* Kn = (bf16_t*)(UT + 64 * 68);
  bf16_t* Qn = Kn + 64 * 136;
  bf16_t* Wm = Qn + 64 * 136;
  bf16_t* SbT = Wm + 64 * 136;
  bf16_t* KdT = SbT + 64 * 136;
  bf16_t* Vn = KdT + 128 * 72;
  bf16_t* QKd = Vn + 64 * 72;
  bf16_t* vnT = (bf16_t*)Af;
  bf16_t* K0 = KdT; bf16_t* K1 = KdT + 64 * 72;
  bf16_t* S0 = (bf16_t*)Af; bf16_t* S1 = S0 + 64 * 72; bf16_t* S2 = S1 + 64 * 72;
  const float* cw = p.in[24] + (size_t)l * 3 * 1536;
  const float dtb = p.in[25][l * 8 + dir * 4 + hh];
  const float Aexp = __expf(p.in[26][l * 8 + dir * 4 + hh]);
  bf16_t* Oout = p.OG + (size_t)dir * NTOK * 512;
  auto ccof = [&](int qd) { return qd < 32 ? hh * 128 + qd * 4 : (qd < 64 ? 512 + hh * 128 + (qd - 32) * 4 : 1024 + hh * 128 + vh * 64 + (qd - 64) * 4); };
  lds_barrier();
  for (int i = tid; i < 64 * 136 / 2; i += NT) ((unsigned*)SbT)[i] = 0u;
  u32x2 rm[5];
  float rga = 0.f, rgb = 0.f;
  auto seg_of = [&](int c, int& L, int& tb, bool& lat, int& ci) {
    if (c < 4) { L = CTXL; tb = NLAT + b * CTXL; lat = false; ci = c; } else { L = SEQ; tb = b * SEQ; lat = true; ci = c - 4; }
  };
  auto do_load = [&](int c, int kb) {
    int L, tb, ci; bool lat; seg_of(c, L, tb, lat, ci);
    int tidl = tid; asm volatile("" : "+v"(tidl));
    int rj_ = (tidl + kb * NT) / 80, rq_ = (tidl + kb * NT) - rj_ * 80;
#pragma unroll
    for (int k = 0; k < 5; ++k) {
      const int j = rj_, qd = rq_;
      rq_ += 32; rj_ += 6; if (rq_ >= 80) { rq_ -= 80; rj_ += 1; }
      const int t = dir == 0 ? ci * 64 + j : L - 1 - (ci * 64 + j);
      rm[k] = *(const u32x2*)(p.P + (size_t)(tb + t) * PLD + PC_GDN + ccof(qd));
    }
    if (kb == 0 && tid < 64) {
      const int t = dir == 0 ? ci * 64 + tid : L - 1 - (ci * 64 + tid);
      const bf16_t* pr = p.P + (size_t)(tb + t) * PLD + PC_GDN + 2048;
      rga = bf2f(pr[dir * 4 + hh]); rgb = bf2f(pr[8 + dir * 4 + hh]);
    }
  };
  auto do_g = [&]() {
    if (tid < 64) {
      float a = -Aexp * softplus_f(rga + dtb);
#pragma unroll
      for (int o = 1; o < 64; o <<= 1) { const float v = __shfl_up(a, o); if (lane >= o) a += v; }
      gcs[tid] = a; bts[tid] = sigmoid_f(rgb);
    }
  };
  auto do_convert = [&](int kb) {
    int tidl = tid; asm volatile("" : "+v"(tidl));
    int rj_ = (tidl + kb * NT) / 80, rq_ = (tidl + kb * NT) - rj_ * 80;
#pragma unroll
    for (int k = 0; k < 5; ++k) {
      const int s = rj_, qd = rq_;
      rq_ += 32; rj_ += 6; if (rq_ >= 80) { rq_ -= 80; rj_ += 1; }
      const u32x2 pk = rm[k];
      bf16_t* dst = qd < 32 ? Qn + s * 136 + qd * 4 : (qd < 64 ? Kn + s * 136 + (qd - 32) * 4 : Vn + s * 72 + (qd - 64) * 4);
      *(u32x2*)dst = pk;
    }
  };
  auto do_norm = [&]() {
#pragma unroll 2
    for (int rr = 0; rr < 8; ++rr) {
      const int s = wid * 8 + rr;
      const float q0 = bf2f(Qn[s * 136 + lane]), q1 = bf2f(Qn[s * 136 + lane + 64]);
      const float k0 = bf2f(Kn[s * 136 + lane]), k1 = bf2f(Kn[s * 136 + lane + 64]);
      float sq = q0 * q0 + q1 * q1, sk = k0 * k0 + k1 * k1;
#pragma unroll
      for (int o = 32; o > 0; o >>= 1) { sq += __shfl_xor(sq, o); sk += __shfl_xor(sk, o); }
      const float cq = rsqrtf(sq + EPS) * 0.08838834764831845f, ck = rsqrtf(sk + EPS);
      Qn[s * 136 + lane] = f2bf(q0 * cq); Qn[s * 136 + lane + 64] = f2bf(q1 * cq);
      const float kn0 = k0 * ck, kn1 = k1 * ck;
      Kn[s * 136 + lane] = f2bf(kn0); Kn[s * 136 + lane + 64] = f2bf(kn1);
    }
  };
  f32x4 Sacc[4];
#pragma unroll
  for (int i = 0; i < 4; ++i) Sacc[i] = (f32x4){0.f, 0.f, 0.f, 0.f};
  do_load(0, 0);
  do_g();
  lds_barrier();
  do_convert(0);
  do_load(0, 5);
  do_convert(5);
  lds_barrier();
  for (int c = 0; c < 36; ++c) {
    if (c + 1 < 36) do_load(c + 1, 0);
    {
    int tA = tid; asm volatile("" : "+v"(tA));
    const int lane = tA & 63, wid = tA >> 6, fr = lane & 15, fq = lane >> 4;
    for (int i = tA; i < 64 * 72 / 2; i += NT) ((unsigned*)K1)[i] = 0u;
#pragma unroll 1
    for (int h = 0; h < 4; ++h) {
      const int tt = wid + 8 * h, kind = tt >> 4, ti = (tt >> 2) & 3, tj = tt & 3;
      f32x4 acc = {0.f, 0.f, 0.f, 0.f};
      if (tj <= ti) {
        const bf16_t* Arow = kind ? Qn : Kn;
#pragma unroll
        for (int kk = 0; kk < 4; ++kk)
          acc = __builtin_amdgcn_mfma_f32_16x16x32_bf16(ldsfrag(Arow, ti * 16 + fr, 136, kk * 32 + fq * 8), ldsfrag(Kn, tj * 16 + fr, 136, kk * 32 + fq * 8), acc, 0, 0, 0);
      }
      const int jc = tj * 16 + fr;
      const float gj = gcs[jc];
#pragma unroll
      for (int jj = 0; jj < 4; ++jj) {
        const int ir = ti * 16 + fq * 4 + jj;
        const float dcy = __expf(gcs[ir] - gj);
        if (kind == 0) {
          const float av = (jc < ir) ? bts[ir] * acc[jj] * dcy : 0.f;
          Af[ir * 68 + jc] = av;
          K0[ir * 72 + jc] = f2bf(tj < ti ? av : 0.f);
        } else QKd[ir * 72 + jc] = f2bf((jc <= ir) ? acc[jj] * dcy : 0.f);
      }
    }
    }
    lds_barrier();
    {
      int tB = tid; asm volatile("" : "+v"(tB));
      const int lane = tB & 63, wid = tB >> 6, fr = lane & 15, fq = lane >> 4;
      if (tB < 64) {
        const int r = tB >> 4, cc = tB & 15;
        float X[16];
#pragma unroll
        for (int ii = 0; ii < 16; ++ii) {
          float sa = (ii == cc) ? 1.f : 0.f, sb = 0.f;
#pragma unroll
          for (int j4 = 0; j4 < (ii + 3) / 4; ++j4) {
            const f32x4 a4 = *(const f32x4*)(Af + (r * 16 + ii) * 68 + r * 16 + j4 * 4);
            if (j4 * 4 + 0 < ii) sa -= a4[0] * X[j4 * 4 + 0];
            if (j4 * 4 + 1 < ii) sb -= a4[1] * X[j4 * 4 + 1];
            if (j4 * 4 + 2 < ii) sa -= a4[2] * X[j4 * 4 + 2];
            if (j4 * 4 + 3 < ii) sb -= a4[3] * X[j4 * 4 + 3];
          }
          X[ii] = sa + sb;
        }
#pragma unroll
        for (int ii = 0; ii < 16; ++ii) K1[(r * 16 + ii) * 72 + r * 16 + cc] = f2bf(X[ii]);
      }
      lds_barrier();
      auto mm = [&](const bf16_t* Xm, const bf16_t* Ym, int ti, int tj) {
        f32x4 acc = {0.f, 0.f, 0.f, 0.f};
#pragma unroll
        for (int kk = 0; kk < 2; ++kk)
          acc = __builtin_amdgcn_mfma_f32_16x16x32_bf16(ldsfrag(Xm, ti * 16 + fr, 72, kk * 32 + fq * 8), trfrag<72>(Ym, kk * 32, tj * 16, fr, fq), acc, 0, 0, 0);
        return acc;
      };
#pragma unroll 1
      for (int h = 0; h < 2; ++h) {
        const int tt = wid + 8 * h, ti = tt >> 2, tj = tt & 3;
        const f32x4 acc = mm(K1, K0, ti, tj);
#pragma unroll
        for (int jj = 0; jj < 4; ++jj) S0[(ti * 16 + fq * 4 + jj) * 72 + tj * 16 + fr] = f2bf(acc[jj]);
      }
      lds_barrier();
#pragma unroll 1
      for (int h = 0; h < 2; ++h) {
        const int tt = wid + 8 * h, ti = tt >> 2, tj = tt & 3;
        const f32x4 acc = mm(S0, S0, ti, tj);
#pragma unroll
        for (int jj = 0; jj < 4; ++jj) S1[(ti * 16 + fq * 4 + jj) * 72 + tj * 16 + fr] = f2bf(acc[jj]);
      }
      lds_barrier();
#pragma unroll 1
      for (int h = 0; h < 2; ++h) {
        const int tt = wid + 8 * h, ti = tt >> 2, tj = tt & 3;
        const f32x4 acc = mm(S0, S1, ti, tj);
#pragma unroll
        for (int jj = 0; jj < 4; ++jj) {
          const int ir = ti * 16 + fq * 4 + jj, jc = tj * 16 + fr;
          const float v = (ir == jc ? 1.f : 0.f) - bf2f(S0[ir * 72 + jc]) + bf2f(S1[ir * 72 + jc]) - acc[jj];
          S2[ir * 72 + jc] = f2bf(v);
        }
      }
      lds_barrier();
#pragma unroll 1
      for (int h = 0; h < 2; ++h) {
        const int tt = wid + 8 * h, ti = tt >> 2, tj = tt & 3;
        const f32x4 acc = mm(S2, K1, ti, tj);
        const int jc = tj * 16 + fr;
        const float bj = bts[jc], bg = bj * __expf(gcs[jc]);
#pragma unroll
        for (int jj = 0; jj < 4; ++jj) {
          const int ir = ti * 16 + fq * 4 + jj;
          K0[ir * 72 + jc] = f2bf(acc[jj] * bj);
          S0[ir * 72 + jc] = f2bf(acc[jj] * bg);
        }
      }
      lds_barrier();
#pragma unroll 1
      for (int h = 0; h < 6; ++h) {
        const int tt = wid + 8 * h;
        if (tt < 16) {
          const int ti = tt >> 2, tv = tt & 3;
          f32x4 acc = {0.f, 0.f, 0.f, 0.f};
#pragma unroll
          for (int kk = 0; kk < 2; ++kk)
            acc = __builtin_amdgcn_mfma_f32_16x16x32_bf16(ldsfrag(K0, ti * 16 + fr, 72, kk * 32 + fq * 8), trfrag<72>(Vn, kk * 32, tv * 16, fr, fq), acc, 0, 0, 0);
          *(f32x4*)(UT + (tv * 16 + fr) * 68 + ti * 16 + fq * 4) = acc;
        } else {
          const int t2 = tt - 16, ti = t2 >> 3, tk = t2 & 7;
          f32x4 acc = {0.f, 0.f, 0.f, 0.f};
#pragma unroll
          for (int kk = 0; kk < 2; ++kk)
            acc = __builtin_amdgcn_mfma_f32_16x16x32_bf16(ldsfrag(S0, ti * 16 + fr, 72, kk * 32 + fq * 8), trfrag<136>(Kn, kk * 32, tk * 16, fr, fq), acc, 0, 0, 0);
#pragma unroll
          for (int jj = 0; jj < 4; ++jj) Wm[(ti * 16 + fq * 4 + jj) * 136 + tk * 16 + fr] = f2bf(acc[jj]);
        }
      }
    }
    lds_barrier();
    int tC = tid; asm volatile("" : "+v"(tC));
    const int lane = tC & 63, wid = tC >> 6, fr = lane & 15, fq = lane >> 4;
    {
      const float glast = gcs[63];
#pragma unroll 2
      for (int idx = tC; idx < 64 * 128; idx += NT) {
        const int sj = idx >> 7, k = idx & 127;
        KdT[k * 72 + sj] = f2bf(bf2f(Kn[sj * 136 + k]) * __expf(glast - gcs[sj]));
      }
    }
#pragma unroll
    for (int h = 0; h < 2; ++h) {
      const int tt = wid + 8 * h, ti = tt >> 2, tv = tt & 3;
      f32x4 acc = {0.f, 0.f, 0.f, 0.f};
#pragma unroll
      for (int kk = 0; kk < 4; ++kk)
        acc = __builtin_amdgcn_mfma_f32_16x16x32_bf16(ldsfrag(Wm, ti * 16 + fr, 136, kk * 32 + fq * 8), ldsfrag(SbT, tv * 16 + fr, 136, kk * 32 + fq * 8), acc, 0, 0, 0);
      const int v = tv * 16 + fr, i0 = ti * 16 + fq * 4;
      const f32x4 u4 = *(const f32x4*)(UT + v * 68 + i0);
      const u32x2 o = {pack2(u4[0] - acc[0], u4[1] - acc[1]), pack2(u4[2] - acc[2], u4[3] - acc[3])};
      *(u32x2*)(vnT + v * 72 + i0) = o;
    }
    lds_barrier();
    {
      int L, tb, ci; bool lat; seg_of(c, L, tb, lat, ci);
#pragma unroll
      for (int h = 0; h < 2; ++h) {
        const int tt = wid + 8 * h, tv = tt >> 2, ti = tt & 3;
        f32x4 acc = {0.f, 0.f, 0.f, 0.f};
#pragma unroll
        for (int kk = 0; kk < 4; ++kk)
          acc = __builtin_amdgcn_mfma_f32_16x16x32_bf16(ldsfrag(SbT, tv * 16 + fr, 136, kk * 32 + fq * 8), ldsfrag(Qn, ti * 16 + fr, 136, kk * 32 + fq * 8), acc, 0, 0, 0);
        const int ir = ti * 16 + fr;
        const float sc = __expf(gcs[ir]);
        acc[0] *= sc; acc[1] *= sc; acc[2] *= sc; acc[3] *= sc;
#pragma unroll
        for (int kk = 0; kk < 2; ++kk)
          acc = __builtin_amdgcn_mfma_f32_16x16x32_bf16(ldsfrag(vnT, tv * 16 + fr, 72, kk * 32 + fq * 8), ldsfrag(QKd, ti * 16 + fr, 72, kk * 32 + fq * 8), acc, 0, 0, 0);
        const int v0 = tv * 16 + fq * 4;
        const int t = dir == 0 ? ci * 64 + ir : L - 1 - (ci * 64 + ir);
        const u32x2 o = {pack2(acc[0], acc[1]), pack2(acc[2], acc[3])};
        *(u32x2*)(Oout + (size_t)(tb + t) * 512 + hh * 128 + vh * 64 + v0) = o;
      }
      const float eg = __expf(gcs[63]);
#pragma unroll
      for (int tv = 0; tv < 4; ++tv) {
        Sacc[tv][0] *= eg; Sacc[tv][1] *= eg; Sacc[tv][2] *= eg; Sacc[tv][3] *= eg;
#pragma unroll
        for (int kk = 0; kk < 2; ++kk)
          Sacc[tv] = __builtin_amdgcn_mfma_f32_16x16x32_bf16(ldsfrag(KdT, wid * 16 + fr, 72, kk * 32 + fq * 8), ldsfrag(vnT, tv * 16 + fr, 72, kk * 32 + fq * 8), Sacc[tv], 0, 0, 0);
      }
    }
    lds_barrier();
#pragma unroll
    for (int tv = 0; tv < 4; ++tv) {
      const u32x2 o = {pack2(Sacc[tv][0], Sacc[tv][1]), pack2(Sacc[tv][2], Sacc[tv][3])};
      *(u32x2*)(SbT + (tv * 16 + fr) * 136 + wid * 16 + fq * 4) = o;
    }
    if (c + 1 < 36) {
      do_g();
      do_convert(0); do_load(c + 1, 5); do_convert(5);
    }
    lds_barrier();
  }
}

DEVI void phase_mixers(const Params& p, int l, bool last, char* smem) {
  if (gridDim.x == 256) {
    const int bi = bidx();
    if (bi < 128) {
      gdn_chain(p, l, bi, smem);
      __syncthreads();
      hyena_channel<2048>(p, l, bi, smem);
    } else {
      ssd_chain(p, l, bi - 128, smem);
      __syncthreads();
      for (int c = 128 + (bi - 128) * 3; c < 128 + (bi - 128) * 3 + 3; ++c) {
        hyena_channel<2048>(p, l, c, smem);
        if (!last) hyena_channel<256>(p, l, c, smem);
      }
      if (!last) hyena_channel<256>(p, l, bi - 128, smem);
    }
  } else {
    for (int item = bidx(); item < 256; item += gridDim.x) {
      if (item < 128) gdn_chain(p, l, item, smem); else ssd_chain(p, l, item - 128, smem);
    }
    __syncthreads();
    for (int c = bidx(); c < 512; c += gridDim.x) {
      hyena_channel<2048>(p, l, c, smem);
      if (!last) hyena_channel<256>(p, l, c, smem);
    }
  }
}

DEVI void phase_post(const Params& p, int l, int ntok, char* smem) {
  const int tid = tidx(), lane = tid & 63;
  {
    bf16_t* tile = (bf16_t*)smem;
    const int ntt = ntok / 64;
    for (int item = bidx(); item < 8 * ntt; item += gridDim.x) {
      const int ct = item % 8, tt = item / 8;
      __syncthreads();
      {
        const int chl = tid >> 3, t8 = (tid & 7) * 8;
        u32x4 v = *(const u32x4*)(p.PT + (size_t)(ct * 64 + chl) * NTOK + tt * 64 + t8);
        *(u32x4*)(tile + chl * 72 + t8) = v;
      }
      __syncthreads();
      {
        const int tl = tid >> 3, c8 = (tid & 7) * 8;
        u32x4 o;
#pragma unroll
        for (int k = 0; k < 4; ++k) o[k] = (unsigned)tile[(c8 + 2 * k) * 72 + tl] | ((unsigned)tile[(c8 + 2 * k + 1) * 72 + tl] << 16);
        *(u32x4*)(p.YH + (size_t)(tt * 64 + tl) * 512 + ct * 64 + c8) = o;
      }
    }
  }
  {
    const bf16_t* YSf = p.H; const bf16_t* YSb = p.H + (size_t)NTOK * 512;
    const bf16_t* OGf = p.OG; const bf16_t* OGb = p.OG + (size_t)NTOK * 512;
    bf16_t* YS = p.PT + (size_t)512 * NTOK;
    bf16_t* YG = p.PT + (size_t)1024 * NTOK;
    const float* snw = p.in[23] + (size_t)l * 512;
    const float* gnw = p.in[27] + (size_t)l * 128;
    const int gw = bidx() * (NT / 64) + (tid >> 6), nw_tot = gridDim.x * (NT / 64);
    const int c8 = lane * 8;
    for (int tok = gw; tok < ntok; tok += nw_tot) {
      {
        u32x4 a = *(const u32x4*)(YSf + (size_t)tok * 512 + c8), bq = *(const u32x4*)(YSb + (size_t)tok * 512 + c8);
        u32x4 z = *(const u32x4*)(p.P + (size_t)tok * PLD + PC_SSM + c8);
        float v[8]; float ss = 0.f;
#pragma unroll
        for (int k = 0; k < 4; ++k) {
          v[2 * k] = (lo2f(a[k]) + lo2f(bq[k])) * silu_f(lo2f(z[k]));
          v[2 * k + 1] = (hi2f(a[k]) + hi2f(bq[k])) * silu_f(hi2f(z[k]));
          ss += v[2 * k] * v[2 * k] + v[2 * k + 1] * v[2 * k + 1];
        }
#pragma unroll
        for (int o = 16; o > 0; o >>= 1) ss += __shfl_xor(ss, o);
        const float rstd = rsqrtf(ss * (1.f / 256.f) + EPS);
        u32x4 o;
#pragma unroll
        for (int k = 0; k < 4; ++k) o[k] = pack2(v[2 * k] * rstd * snw[c8 + 2 * k], v[2 * k + 1] * rstd * snw[c8 + 2 * k + 1]);
        *(u32x4*)(YS + (size_t)tok * 512 + c8) = o;
      }
      {
        u32x4 a = *(const u32x4*)(OGf + (size_t)tok * 512 + c8), bq = *(const u32x4*)(OGb + (size_t)tok * 512 + c8);
        u32x4 gt = *(const u32x4*)(p.P + (size_t)tok * PLD + PC_GDN + 1536 + c8);
        float v[8]; float ss = 0.f;
#pragma unroll
        for (int k = 0; k < 4; ++k) {
          v[2 * k] = lo2f(a[k]) + lo2f(bq[k]);
          v[2 * k + 1] = hi2f(a[k]) + hi2f(bq[k]);
          ss += v[2 * k] * v[2 * k] + v[2 * k + 1] * v[2 * k + 1];
        }
#pragma unroll
        for (int o = 8; o > 0; o >>= 1) ss += __shfl_xor(ss, o);
        const float rstd = rsqrtf(ss * (1.f / 128.f) + EPS);
        const int ci = c8 & 127;
        u32x4 o;
#pragma unroll
        for (int k = 0; k < 4; ++k)
          o[k] = pack2(v[2 * k] * rstd * gnw[ci + 2 * k] * silu_f(lo2f(gt[k])), v[2 * k + 1] * rstd * gnw[ci + 2 * k + 1] * silu_f(hi2f(gt[k])));
        *(u32x4*)(YG + (size_t)tok * 512 + c8) = o;
      }
    }
  }
}

DEVI void phase_final(const Params& p) {
  const int lane = tidx() & 63;
  const int gw = bidx() * (NT / 64) + (tidx() >> 6), nw_tot = gridDim.x * (NT / 64);
  const float* nw = p.in[34];
  for (int tok = gw; tok < NLAT; tok += nw_tot) {
    float* xr = p.out + (size_t)tok * D;
    f32x4 v[4]; float ss = 0.f;
#pragma unroll
    for (int i = 0; i < 4; ++i) {
      v[i] = *(const f32x4*)(xr + i * 256 + lane * 4);
      ss += v[i][0] * v[i][0] + v[i][1] * v[i][1] + v[i][2] * v[i][2] + v[i][3] * v[i][3];
    }
#pragma unroll
    for (int o = 32; o > 0; o >>= 1) ss += __shfl_xor(ss, o);
    const float rstd = rsqrtf(ss * (1.f / 1024.f) + EPS);
#pragma unroll
    for (int i = 0; i < 4; ++i) {
      f32x4 w = *(const f32x4*)(nw + i * 256 + lane * 4);
      f32x4 o = {v[i][0] * rstd * w[0], v[i][1] * rstd * w[1], v[i][2] * rstd * w[2], v[i][3] * rstd * w[3]};
      *(f32x4*)(xr + i * 256 + lane * 4) = o;
    }
  }
}

#define XB_TMO      128
#define XB_XCNT(j)  (256  + 64 * (j))
#define XB_XSUB(j)  (1280 + 64 * (j))
#define XB_XGEN(j)  (2304 + 64 * (j))
#define XB_TOP      3328
#define XB_TOPGEN   3392
#define XCD_BAR_WORDS 3456
#define XB_SPIN_CAP (1u << 22)
#define XB_LAS __attribute__((address_space(3)))
DEVI unsigned xb_ld(unsigned* p) { return __hip_atomic_load(p, __ATOMIC_RELAXED, __HIP_MEMORY_SCOPE_AGENT); }
DEVI unsigned xb_add(unsigned* p, unsigned v) { return __hip_atomic_fetch_add(p, v, __ATOMIC_RELAXED, __HIP_MEMORY_SCOPE_AGENT); }
DEVI unsigned xb_xcc_id() { return (unsigned)__builtin_amdgcn_s_getreg((3 << 11) | 20) & 0xFu; }
#define XB_SPIN(cond, bar) do { unsigned _sp = 0; while (cond) { __builtin_amdgcn_s_sleep(1); \
    if ((++_sp & 255u) == 0u) { if (xb_ld(&(bar)[XB_TMO])) break; if (_sp > XB_SPIN_CAP) { atomicAdd(&(bar)[XB_TMO], 1u); break; } } } } while (0)
struct XcdBarrier { unsigned* bar; unsigned x; volatile XB_LAS unsigned* st; };
DEVI XcdBarrier xcd_barrier_post(unsigned* bar, volatile XB_LAS unsigned* st) {
  XcdBarrier b; b.bar = bar; b.x = xb_xcc_id(); b.st = st;
  if (threadIdx.x == 0) (void)xb_add(&bar[XB_XCNT(b.x)], 1u);
  return b;
}
DEVI void xcd_barrier_complete(unsigned* bar, unsigned x, unsigned& nloc, unsigned& nx) {
  const unsigned G = gridDim.x * gridDim.y * gridDim.z;
  unsigned sum, cnt, mine, sp = 0u;
  for (;;) {
    sum = 0u; cnt = 0u; mine = 0u;
#pragma unroll
    for (unsigned j = 0; j < 16; ++j) { const unsigned c = xb_ld(&bar[XB_XCNT(j)]); sum += c; cnt += (c > 0u) ? 1u : 0u; mine = (j == x) ? c : mine; }
    if (sum == G) break;
    __builtin_amdgcn_s_sleep(1);
    if ((++sp & 255u) == 0u) { if (xb_ld(&bar[XB_TMO])) break; if (sp > XB_SPIN_CAP) { atomicAdd(&bar[XB_TMO], 1u); break; } }
  }
  nloc = mine > 0u ? mine : 1u; nx = cnt > 0u ? cnt : 1u;
}
DEVI void xcd_barrier(const XcdBarrier& b) {
  asm volatile("s_waitcnt vmcnt(0)" ::: "memory");
  __syncthreads();
  if (threadIdx.x == 0) {
    unsigned* bar = b.bar;
    __builtin_amdgcn_s_waitcnt(0);
    unsigned nloc = b.st[0], nx = b.st[1];
    if (nloc == 0u) { xcd_barrier_complete(bar, b.x, nloc, nx); b.st[0] = nloc; b.st[1] = nx; }
    const unsigned old = xb_add(&bar[XB_XSUB(b.x)], 1u);
    const unsigned gen = old / nloc;
    if (old + 1u == (gen + 1u) * nloc) {
      __builtin_amdgcn_fence(__ATOMIC_RELEASE, "agent");
      asm volatile("s_waitcnt vmcnt(0)" ::: "memory");
      const unsigned og = xb_add(&bar[XB_TOP], 1u);
      const unsigned tg = og / nx;
      if (og + 1u == (tg + 1u) * nx) xb_add(&bar[XB_TOPGEN], 1u);
      else XB_SPIN(xb_ld(&bar[XB_TOPGEN]) == tg, bar);
      __builtin_amdgcn_fence(__ATOMIC_ACQUIRE, "agent");
      xb_add(&bar[XB_XGEN(b.x)], 1u);
      asm volatile("s_waitcnt vmcnt(0)" ::: "memory");
    } else {
      XB_SPIN(xb_ld(&bar[XB_XGEN(b.x)]) == gen, bar);
      __builtin_amdgcn_fence(__ATOMIC_ACQUIRE, "agent");
      asm volatile("s_waitcnt vmcnt(0)" ::: "memory");
    }
  }
  __syncthreads();
}

#ifndef PSEL
#define PSEL -1
#endif
#ifndef PMASK
#define PMASK 0xffffffffu
#endif
#define RUN(n, ...) if ((PSEL < 0 || PSEL == (n)) && ((PMASK >> (n)) & 1u)) { __VA_ARGS__; }
__global__ void __launch_bounds__(NT, 1) fwd_megakernel(Params p) {
  extern __shared__ __attribute__((aligned(16))) char smem[];
  cg::grid_group grid = cg::this_grid();
  __shared__ uint4 xb_words;
  if (threadIdx.x == 0) xb_words = make_uint4(0u, 0u, 0u, 0u);
  __syncthreads();
  const XcdBarrier xb = xcd_barrier_post(p.bar, (volatile XB_LAS unsigned*)&xb_words);
  RUN(0, phase_mod(p, smem));
  for (int l = 0; l < DEPTH; ++l) {
    const bool last = (l == DEPTH - 1);
    const float* xlat = l == 0 ? p.in[0] : p.out;
    const float* xctx = l == 0 ? p.in[2] : p.xctx;
    const float* modl = p.mod + (size_t)l * 9 * 6144;
    __syncthreads();
    RUN(1, phase_wconv(p, l, smem));
    __syncthreads();
    RUN(2, phase_filters(p, l, smem));
    if (l == 0) grid.sync();
    RUN(3, phase_norm(p, xlat, xctx, p.in[6] + (size_t)l * D, modl, 0, 1, NTOK));
    xcd_barrier(xb);
    RUN(4, phase_gemm_in(p, smem));
    xcd_barrier(xb);
    RUN(4, phase_act(p, l));
    xcd_barrier(xb);
    RUN(5, phase_mixers(p, l, last, smem));
    xcd_barrier(xb);
    const int ntok = last ? NLAT : NTOK;
    RUN(6, phase_post(p, l, ntok, smem));
    xcd_barrier(xb);
    RUN(7, phase_gemm_merge(p, ntok, smem));
    xcd_barrier(xb);
    RUN(8, phase_gemm_resid(p, p.H, 1024, p.W + W_O, 1024, ntok, xlat, xctx, modl, 2, smem));
    xcd_barrier(xb);
    RUN(9, phase_norm(p, p.out, p.xctx, p.in[7] + (size_t)l * D, modl, 3, 4, ntok));
    xcd_barrier(xb);
    RUN(10, phase_gemm_gateup(p, ntok, smem));
    xcd_barrier(xb);
    RUN(11, phase_gemm_resid(p, p.P, DFF, p.W + W_DN, DFF, ntok, p.out, p.xctx, modl, 5, smem));
    xcd_barrier(xb);
  }
  RUN(12, phase_final(p));
}

extern "C" void kernel_launch(void* const* d_in, const int* in_sizes, int n_in, void* d_out, int out_size, void* d_ws, size_t ws_size,
                              hipStream_t stream) {
  Params p{};
  for (int i = 0; i < 35; ++i) p.in[i] = (const float*)d_in[i];
  p.out = (float*)d_out;
  char* ws = (char*)d_ws;
  size_t off = 0;
  auto take = [&](size_t bytes) { char* r = ws + off; off += (bytes + 255) & ~(size_t)255; return r; };
  p.xctx = (float*)take((size_t)NCTX * D * 4);
  p.mod = (float*)take((size_t)4 * 9 * 6144 * 4);
  p.H = (bf16_t*)take((size_t)NTOK * D * 2);
  p.PT = (bf16_t*)take((size_t)HYC * NTOK * 2);
  p.P = (bf16_t*)take((size_t)NTOK * PLD * 2);
  p.YH = (bf16_t*)take((size_t)NTOK * 512 * 2);
  p.OG = (bf16_t*)take((size_t)2 * NTOK * 512 * 2);
  p.W = (bf16_t*)take(W_TOTAL * 2);
  p.KG = (bf16_t*)take(KG_TOTAL * 2);
  p.bar = (unsigned*)take(XCD_BAR_WORDS * 4);
  if (off > ws_size) { fprintf(stderr, "workspace too small: need %zu have %zu\n", off, ws_size); return; }
  hipMemsetAsync(p.bar, 0, XCD_BAR_WORDS * 4, stream);
  hipFuncSetAttribute((const void*)fwd_megakernel, hipFuncAttributeMaxDynamicSharedMemorySize, SMEM_BYTES);
  void* args[] = {&p};
  hipError_t e = hipLaunchCooperativeKernel((void*)fwd_megakernel, dim3(256), dim3(NT), args, SMEM_BYTES, stream);
  if (e != hipSuccess) fprintf(stderr, "cooperative launch failed: %s\n", hipGetErrorString(e));
}
```
